# Optimizing an MI355X kernel written in HIP

```python
import math
import jax, jax.numpy as jnp
from jax import lax
import numpy as np

D_MODEL = 1024
BATCH = 8
SEQ = 2048
DEPTH = 4

HEAD_DIM = 64
W_BR = D_MODEL // 2
N_BRANCH = 3
H_A = W_BR // HEAD_DIM
MOBA_BLOCK = 256
MOBA_TOPK = 3
MOBA_QCHUNK = 32
DIL_PAIRS = ((128, 1), (512, 4), (2048, 16))
N_DIL = len(DIL_PAIRS)
H_B = W_BR // HEAD_DIM
DIL_QCHUNK = 64
H_C = W_BR // HEAD_DIM
KV_C = 2
SWA_WINDOW = 128
N_BUCKETS = 32
REL_MAX_DIST = 2048
H_TOT = H_A + N_DIL * H_B + H_C
OFF_A = 0
OFF_B = H_A
OFF_C = H_A + N_DIL * H_B

EPS = 1e-6
NEG_INF = -1e30

SPLIT_SIZES = ([W_BR] * 4
               + [N_DIL * W_BR] * 3 + [W_BR]
               + [W_BR, KV_C * HEAD_DIM, KV_C * HEAD_DIM, W_BR]
               + [N_BRANCH * D_MODEL])
C_IN = int(sum(SPLIT_SIZES))
SPLIT_POINTS = [int(v) for v in np.cumsum(SPLIT_SIZES)[:-1]]

kernel_name = "hybrid_moba_dilated_swa_gated_trunk"


def rms_norm(x, g):
    x32 = x.astype(jnp.float32)
    y = x32 * lax.rsqrt(jnp.mean(x32 * x32, axis=-1, keepdims=True) + EPS)
    return (y * g.astype(jnp.float32)).astype(x.dtype)


def rel_bucket(dist):
    dist = jnp.maximum(dist, 0)
    max_exact = N_BUCKETS // 2
    log_ratio = jnp.log(jnp.maximum(dist, 1).astype(jnp.float32) / max_exact) / math.log(REL_MAX_DIST / max_exact)
    large = max_exact + (log_ratio * (N_BUCKETS - max_exact)).astype(jnp.int32)
    large = jnp.minimum(large, N_BUCKETS - 1)
    return jnp.where(dist < max_exact, dist, large)


def moba_attention(q, k, v, bias_tab):
    b, s, h, dh = q.shape
    s_pad = -(-s // MOBA_BLOCK) * MOBA_BLOCK
    pad = ((0, 0), (0, s_pad - s), (0, 0), (0, 0))
    qh, kh, vh = [jnp.pad(t, pad).transpose(0, 2, 1, 3) for t in (q, k, v)]
    nb = s_pad // MOBA_BLOCK
    kb = kh.reshape(b, h, nb, MOBA_BLOCK, dh)
    vb = vh.reshape(b, h, nb, MOBA_BLOCK, dh)
    k_mean = jnp.mean(kb.astype(jnp.float32), axis=3)
    gate = jnp.einsum('bhsd,bhnd->bhsn', qh.astype(jnp.float32), k_mean)
    q_blk = jnp.arange(s_pad) // MOBA_BLOCK
    past = jnp.arange(nb)[None, :] < q_blk[:, None]
    gate = jnp.where(past, gate, NEG_INF)
    n_sel = min(MOBA_TOPK, max(nb - 1, 1))
    _, top_idx = lax.top_k(gate, n_sel)
    sel_valid = jnp.arange(n_sel)[None, :] < jnp.minimum(q_blk, MOBA_TOPK)[:, None]
    scale = dh ** -0.5
    bias_tab = bias_tab.astype(jnp.float32)
    b_idx = jnp.arange(b)[:, None, None, None]
    h_idx = jnp.arange(h)[None, :, None, None]
    h_idx5 = jnp.arange(h)[None, :, None, None, None]
    blk_off = jnp.arange(MOBA_BLOCK)

    def chunk(c):
        t0 = c * MOBA_QCHUNK
        t = t0 + jnp.arange(MOBA_QCHUNK)
        q_c = lax.dynamic_slice_in_dim(qh, t0, MOBA_QCHUNK, axis=2)
        idx_c = lax.dynamic_slice_in_dim(top_idx, t0, MOBA_QCHUNK, axis=2)
        valid_c = lax.dynamic_slice_in_dim(sel_valid, t0, MOBA_QCHUNK, axis=0)
        k_sel = kb[b_idx, h_idx, idx_c]
        v_sel = vb[b_idx, h_idx, idx_c]
        s_sel = jnp.einsum('bhqd,bhqjkd->bhqjk', q_c, k_sel,
                           preferred_element_type=jnp.float32) * scale
        key_pos = idx_c[..., None] * MOBA_BLOCK + blk_off
        dist = t[:, None, None] - key_pos
        bias_sel = bias_tab[h_idx5, rel_bucket(dist)]
        s_sel = jnp.where(valid_c[:, :, None], s_sel + bias_sel, NEG_INF)
        n_own = t0 // MOBA_BLOCK
        k_own = lax.dynamic_index_in_dim(kb, n_own, axis=2, keepdims=False)
        v_own = lax.dynamic_index_in_dim(vb, n_own, axis=2, keepdims=False)
        s_own = jnp.einsum('bhqd,bhkd->bhqk', q_c, k_own,
                           preferred_element_type=jnp.float32) * scale
        dist_own = t[:, None] - (n_own * MOBA_BLOCK + blk_off)[None, :]
        s_own = jnp.where(dist_own >= 0, s_own + bias_tab[:, rel_bucket(dist_own)], NEG_INF)
        n_s = n_sel * MOBA_BLOCK
        logits = jnp.concatenate([s_sel.reshape(b, h, MOBA_QCHUNK, n_s), s_own], axis=-1)
        p = jax.nn.softmax(logits, axis=-1)
        p_sel = p[..., :n_s].reshape(b, h, MOBA_QCHUNK, n_sel, MOBA_BLOCK).astype(v.dtype)
        p_own = p[..., n_s:].astype(v.dtype)
        out = (jnp.einsum('bhqjk,bhqjkd->bhqd', p_sel, v_sel, preferred_element_type=jnp.float32)
               + jnp.einsum('bhqk,bhkd->bhqd', p_own, v_own, preferred_element_type=jnp.float32))
        return out.astype(v.dtype)

    out = lax.map(chunk, jnp.arange(s_pad // MOBA_QCHUNK))
    out = out.transpose(1, 0, 3, 2, 4).reshape(b, s_pad, h, dh)
    return out[:, :s]


def dilated_attention(q, k, v, bias_tab):
    b, s, _, h, dh = q.shape
    scale = dh ** -0.5
    bias_tab = bias_tab.astype(jnp.float32)
    n_keys = [w // d + 1 for (w, d) in DIL_PAIRS]
    k_pads = [jnp.pad(k[:, :, gi], ((0, 0), (w, 0), (0, 0), (0, 0))) for gi, (w, d) in enumerate(DIL_PAIRS)]
    v_pads = [jnp.pad(v[:, :, gi], ((0, 0), (w, 0), (0, 0), (0, 0))) for gi, (w, d) in enumerate(DIL_PAIRS)]
    bias_g = [bias_tab[gi * h:(gi + 1) * h][:, rel_bucket(d * jnp.arange(n_keys[gi]))]
              for gi, (w, d) in enumerate(DIL_PAIRS)]

    def chunk(c):
        t0 = c * DIL_QCHUNK
        t = t0 + jnp.arange(DIL_QCHUNK)
        q_c = lax.dynamic_slice_in_dim(q, t0, DIL_QCHUNK, axis=1)
        outs, lses = [], []
        for gi, (w, d) in enumerate(DIL_PAIRS):
            steps = jnp.arange(n_keys[gi]) * d
            idx = t[:, None] + w - steps[None, :]
            k_g = k_pads[gi][:, idx]
            v_g = v_pads[gi][:, idx]
            logits = jnp.einsum('bqhd,bqjhd->bhqj', q_c[:, :, gi], k_g,
                                preferred_element_type=jnp.float32) * scale + bias_g[gi][:, None, :]
            logits = jnp.where((t[:, None] - steps[None, :]) >= 0, logits, NEG_INF)
            lse = jax.nn.logsumexp(logits, axis=-1)
            p = jnp.exp(logits - lse[..., None]).astype(v.dtype)
            outs.append(jnp.einsum('bhqj,bqjhd->bqhd', p, v_g, preferred_element_type=jnp.float32))
            lses.append(lse)
        wts = jax.nn.softmax(jnp.stack(lses, axis=0), axis=0)
        out = sum(wts[gi].transpose(0, 2, 1)[..., None] * outs[gi] for gi in range(N_DIL))
        return out.astype(v.dtype)

    out = lax.map(chunk, jnp.arange(s // DIL_QCHUNK))
    return out.transpose(1, 0, 2, 3, 4).reshape(b, s, h, dh)


def swa_sink_attention(q, k, v, sinks, bias_tab):
    b, s, h, dh = q.shape
    kvh = k.shape[2]
    rep = h // kvh
    W = SWA_WINDOW
    nb = s // W
    scale = dh ** -0.5
    qb = q.reshape(b, nb, W, kvh, rep, dh)
    kb = k.reshape(b, nb, W, kvh, dh)
    vb = v.reshape(b, nb, W, kvh, dh)

    def with_prev(t):
        prev = jnp.pad(t, ((0, 0), (1, 0), (0, 0), (0, 0), (0, 0)))[:, :-1]
        return jnp.concatenate([prev, t], axis=2)

    kk, vv = with_prev(kb), with_prev(vb)
    logits = jnp.einsum('bnqgrd,bnkgd->bngrqk', qb, kk,
                        preferred_element_type=jnp.float32) * scale
    i = jnp.arange(W)
    j = jnp.arange(2 * W)
    dist = i[:, None] + W - j[None, :]
    key_pos = jnp.arange(nb)[:, None] * W - W + j[None, :]
    valid = ((dist >= 0) & (dist < W))[None] & (key_pos >= 0)[:, None, :]
    bias = bias_tab.astype(jnp.float32)[:, rel_bucket(dist)].reshape(kvh, rep, W, 2 * W)
    logits = jnp.where(valid[None, :, None, None], logits + bias, NEG_INF)
    sink = sinks.astype(jnp.float32).reshape(kvh, rep)[None, None, :, :, None, None]
    m = jnp.maximum(jnp.max(logits, axis=-1, keepdims=True), sink)
    e = jnp.exp(logits - m)
    p = e / (jnp.sum(e, axis=-1, keepdims=True) + jnp.exp(sink - m))
    out = jnp.einsum('bngrqk,bnkgd->bnqgrd', p.astype(v.dtype), vv, preferred_element_type=jnp.float32)
    return out.reshape(b, s, h, dh).astype(v.dtype)


def setup_inputs(seed: int = 0) -> dict:
    key = jax.random.key(seed)
    ks = jax.random.split(key, 8)
    x = jax.random.normal(ks[0], (BATCH, SEQ, D_MODEL), jnp.float32)
    ln_g = 1.0 + 0.02 * jax.random.normal(ks[1], (DEPTH, D_MODEL), jnp.float32)
    w_in = jax.random.normal(ks[2], (DEPTH, D_MODEL, C_IN), jnp.float32) * D_MODEL ** -0.5
    qk_g = 1.0 + 0.02 * jax.random.normal(ks[3], (DEPTH, 6, HEAD_DIM), jnp.float32)
    sinks = 0.5 * jax.random.normal(ks[4], (DEPTH, H_C), jnp.float32)
    w_branch = jax.random.normal(ks[5], (DEPTH, N_BRANCH, W_BR, D_MODEL), jnp.float32) * W_BR ** -0.5
    w_out = jax.random.normal(ks[6], (DEPTH, D_MODEL, D_MODEL), jnp.float32) * D_MODEL ** -0.5
    rel_bias = 0.2 * jax.random.normal(ks[7], (H_TOT, N_BUCKETS), jnp.float32)
    return {"x": x, "ln_g": ln_g, "w_in": w_in, "qk_g": qk_g, "sinks": sinks,
            "w_branch": w_branch, "w_out": w_out, "rel_bias": rel_bias}


def reference(x, ln_g, w_in, qk_g, sinks, w_branch, w_out, rel_bias):
    b, s, _ = x.shape
    for l in range(DEPTH):
        hn = rms_norm(x, ln_g[l])
        proj = jnp.einsum('bsd,dc->bsc', hn, w_in[l])
        (qa, ka, va, ga, qb, kb, vb, gb, qc, kc, vc, gc, gate_logits) = jnp.split(proj, SPLIT_POINTS, axis=-1)
        g = qk_g[l]
        qa = rms_norm(qa.reshape(b, s, H_A, HEAD_DIM), g[0])
        ka = rms_norm(ka.reshape(b, s, H_A, HEAD_DIM), g[1])
        o_a = moba_attention(qa, ka, va.reshape(b, s, H_A, HEAD_DIM), rel_bias[OFF_A:OFF_A + H_A])
        qb = rms_norm(qb.reshape(b, s, N_DIL, H_B, HEAD_DIM), g[2])
        kb = rms_norm(kb.reshape(b, s, N_DIL, H_B, HEAD_DIM), g[3])
        o_b = dilated_attention(qb, kb, vb.reshape(b, s, N_DIL, H_B, HEAD_DIM),
                                rel_bias[OFF_B:OFF_B + N_DIL * H_B])
        qc = rms_norm(qc.reshape(b, s, H_C, HEAD_DIM), g[4])
        kc = rms_norm(kc.reshape(b, s, KV_C, HEAD_DIM), g[5])
        o_c = swa_sink_attention(qc, kc, vc.reshape(b, s, KV_C, HEAD_DIM), sinks[l],
                                 rel_bias[OFF_C:OFF_C + H_C])
        branches = jnp.stack([o_a.reshape(b, s, W_BR) * jax.nn.silu(ga),
                              o_b.reshape(b, s, W_BR) * jax.nn.silu(gb),
                              o_c.reshape(b, s, W_BR) * jax.nn.silu(gc)], axis=2)
        br = jnp.einsum('bsiw,iwd->bsid', branches, w_branch[l])
        gates = jax.nn.sigmoid(gate_logits.reshape(b, s, N_BRANCH, D_MODEL))
        merged = jnp.sum(gates * br, axis=2)
        x = x + jnp.einsum('bsd,de->bse', merged, w_out[l])
    return x
```

```cpp
#include <hip/hip_runtime.h>
#include <cstdio>
#include <cstdint>

#ifndef DBG_PH
#define DBG_PH 31
#endif
#ifndef MK_PER_PHASE
#define MK_PER_PHASE 0
#endif

constexpr int BATCH = 8, SEQ = 2048, DM = 1024, DEPTH = 4, HD = 64, WBR = 512;
constexpr int M = BATCH * SEQ;
constexpr int CIN = 11520;
constexpr int NBUCK = 32, NH_TOT = 40, OFF_A = 0, OFF_B = 8, OFF_C = 32;
constexpr int C_QA = 0, C_KA = 512, C_VA = 1024, C_GA = 1536, C_QB = 2048, C_KB = 3584, C_VB = 5120, C_GB = 6656, C_QC = 7168, C_KC = 7680, C_VC = 7808, C_GC = 7936, C_GL = 8448;
constexpr float LOG2E = 1.4426950408889634f;
constexpr float C2 = 0.125f * LOG2E;
constexpr float EPS = 1e-6f;
constexpr int BRP = 3 * WBR;

namespace pg8 {
#define PG8_LAS __attribute__((address_space(3)))
typedef unsigned short bf16_t;
typedef short bf16x8 __attribute__((ext_vector_type(8)));
typedef float f32x4 __attribute__((ext_vector_type(4)));
typedef unsigned u32x4 __attribute__((ext_vector_type(4)));
typedef unsigned u32x2 __attribute__((ext_vector_type(2)));
constexpr int BM = 256, BK = 64, HALF = 128, HTB = HALF * BK * 2, STAGE_BYTES = 8 * HTB, NXCD = 8, WGM = 8;

__host__ __device__ __forceinline__ int lds_byte(int r, int c) { const int st = (r >> 4) * 2 + (c >> 5), rr = r & 15, cc = c & 31, ob = rr * 64 + cc * 2; return st * 1024 + (ob ^ (((ob >> 9) & 1) << 5)); }
__host__ __device__ __forceinline__ void stage_rc(int b, int& R, int& C) { const int st = b / 1024, sb = b % 1024, swz = sb ^ (((sb >> 9) & 1) << 5); R = (st >> 1) * 16 + swz / 64; C = (st & 1) * 32 + (swz % 64) / 2; }
__host__ __device__ __forceinline__ int perm32(int rho) { const int n = rho >> 4, i = rho & 15; return 8 * (i >> 2) + 4 * n + (i & 3); }

struct Unit { int pm, pn; };
struct Gemm { const bf16_t* A; const bf16_t* Bt; int M, N, K; };

struct StaticOrder {
    int nM, nN, nwg, G, c;
    __host__ __device__ void init(int M_, int N_, int G_, int c_) { nM = M_ / BM; nN = N_ / BM; nwg = nM * nN; G = G_; c = c_; }
    __host__ __device__ bool next(int i, Unit& u) const {
        const long L = (long)i * G + c; if (L >= nwg) return false;
        int wgid = (int)L; { const int q = nwg / NXCD, r = nwg % NXCD, xcd = wgid % NXCD, off = wgid / NXCD; wgid = (xcd < r ? xcd * (q + 1) : r * (q + 1) + (xcd - r) * q) + off; }
        const int nig = WGM * nN, gid = wgid / nig, fm = gid * WGM, gsz = (nM - fm) < WGM ? (nM - fm) : WGM;
        u.pm = fm + ((wgid % nig) % gsz); u.pn = (wgid % nig) / gsz; return true;
    }
    __device__ __forceinline__ void a_ready(const Unit&) const {}
    __device__ __forceinline__ void done(const Unit&) const {}
};

typedef float f32x2 __attribute__((ext_vector_type(2)));
typedef __bf16 bf16x2_t __attribute__((ext_vector_type(2)));
__device__ __forceinline__ unsigned cvt_pk_bf16(float lo, float hi) { f32x2 v = {lo, hi}; bf16x2_t b = __builtin_convertvector(v, bf16x2_t); return __builtin_bit_cast(unsigned, b); }
__device__ __forceinline__ float bf_lo(unsigned w) { return __builtin_bit_cast(float, w << 16); }
__device__ __forceinline__ float bf_hi(unsigned w) { return __builtin_bit_cast(float, w & 0xffff0000u); }

template <class Epi, class Sched, bool ALIGN_EPI = false, bool SP2 = false>
__device__ __forceinline__ void gemm_phase(PG8_LAS unsigned char* lds, const Gemm g, const Sched& S, const Epi& E) {
    int tid_ = threadIdx.x; asm volatile("" : "+v"(tid_));
    const int tid = tid_, wid = __builtin_amdgcn_readfirstlane(tid >> 6), lane = tid & 63, wr = wid >> 2, wc = wid & 3, fr = lane & 15, fq = lane >> 4;
    const int K = g.K, nt = K / BK;
    unsigned voffA[2], voffB[2];
#pragma unroll
    for (int i = 0; i < 2; ++i) { int R, C; stage_rc(tid * 16 + i * 8192, R, C); const int Rb = Epi::PERM ? ((R & ~31) + perm32(R & 31)) : R;
        voffA[i] = (unsigned)(R * K + C) * 2u; voffB[i] = (unsigned)(Rb * K + C) * 2u; }
    const size_t kstep = (size_t)(BK * 2);
    const size_t hstep = (size_t)HALF * K * 2;
    const size_t tstep = 2 * hstep;
    const unsigned ldsw = (unsigned)wid * 1024u;
    const int aoff = lds_byte(wr * 64 + fr, fq * 8), boff = lds_byte(wc * 32 + fr, fq * 8);
#define PG8_SA(b, h) (((b) * 2 + (h)) * HTB)
#define PG8_SB(b, h) ((4 + (b) * 2 + (h)) * HTB)
#define PG8_STAGE(bufoff, gbase, voff) do { _Pragma("unroll") for (int _i = 0; _i < 2; ++_i) \
        __builtin_amdgcn_global_load_lds((const unsigned*)((const char*)(gbase) + (voff)[_i]), (PG8_LAS unsigned*)(lds + (bufoff) + ldsw + _i * 8192), 16, 0, 0); } while (0)
#define PG8_LDA(dst, b, h) do { _Pragma("unroll") for (int m = 0; m < 4; ++m) _Pragma("unroll") for (int k = 0; k < 2; ++k) dst[m][k] = *(const PG8_LAS bf16x8*)(lds + PG8_SA(b, h) + aoff + m * 2048 + k * 1024); } while (0)
#define PG8_LDB(dst, b, h) do { _Pragma("unroll") for (int n = 0; n < 2; ++n) _Pragma("unroll") for (int k = 0; k < 2; ++k) dst[n][k] = *(const PG8_LAS bf16x8*)(lds + PG8_SB(b, h) + boff + n * 2048 + k * 1024); } while (0)
#define PG8_MMA(ai, bj, At, Bt) do { __builtin_amdgcn_s_setprio(1); _Pragma("unroll") for (int m = 0; m < 4; ++m) _Pragma("unroll") for (int n = 0; n < 2; ++n) _Pragma("unroll") for (int k = 0; k < 2; ++k) \
        acc[ai][bj][m][n] = __builtin_amdgcn_mfma_f32_16x16x32_bf16(Bt[n][k], At[m][k], acc[ai][bj][m][n], 0, 0, 0); __builtin_amdgcn_s_setprio(0); } while (0)
#define PG8_WAIT_V(n) asm volatile("s_waitcnt vmcnt(" #n ")" ::: "memory")
#define PG8_WAIT_L(n) asm volatile("s_waitcnt lgkmcnt(" #n ")" ::: "memory")
#define PG8_BAR __builtin_amdgcn_s_barrier()
#define PG8_SCHED __builtin_amdgcn_sched_barrier(0)
    Unit cur, nxt; int ui = 0;
    if (!S.next(0, cur)) return;
    f32x4 acc[2][2][4][2];
#pragma unroll
    for (int a = 0; a < 2; ++a)
#pragma unroll
        for (int b = 0; b < 2; ++b)
#pragma unroll
            for (int m = 0; m < 4; ++m)
#pragma unroll
                for (int n = 0; n < 2; ++n) acc[a][b][m][n] = (f32x4){0.f, 0.f, 0.f, 0.f};
    bf16x8 At[4][2], B0[2][2], B1[2][2];
    const char* cA = (const char*)g.A + (size_t)cur.pm * tstep; const char* cB = (const char*)g.Bt + (size_t)cur.pn * tstep;
    S.a_ready(cur);
    if constexpr (SP2) {
        PG8_STAGE(PG8_SB(0, 0), cB, voffB); PG8_STAGE(PG8_SB(0, 1), cB + hstep, voffB); PG8_STAGE(PG8_SA(0, 0), cA, voffA); PG8_STAGE(PG8_SA(0, 1), cA + hstep, voffA);
        if (wr == 1) PG8_BAR;
        PG8_WAIT_V(2); PG8_BAR;
        PG8_STAGE(PG8_SB(1, 0), cB + kstep, voffB); PG8_STAGE(PG8_SA(1, 0), cA + kstep, voffA); PG8_STAGE(PG8_SB(1, 1), cB + hstep + kstep, voffB);
        PG8_WAIT_V(6); PG8_BAR;
    } else {
        PG8_STAGE(PG8_SB(0, 0), cB, voffB); PG8_STAGE(PG8_SA(0, 0), cA, voffA); PG8_STAGE(PG8_SB(0, 1), cB + hstep, voffB); PG8_STAGE(PG8_SA(0, 1), cA + hstep, voffA);
        if (wr == 1) PG8_BAR;
        PG8_WAIT_V(4); PG8_BAR;
        PG8_STAGE(PG8_SB(1, 0), cB + kstep, voffB); PG8_STAGE(PG8_SA(1, 0), cA + kstep, voffA); PG8_STAGE(PG8_SB(1, 1), cB + hstep + kstep, voffB);
        PG8_WAIT_V(6); PG8_BAR;
    }
    for (;;) {
        const bool has_next = S.next(ui + 1, nxt);
        const char* nA = has_next ? (const char*)g.A + (size_t)nxt.pm * tstep : cA; const char* nB = has_next ? (const char*)g.Bt + (size_t)nxt.pn * tstep : cB;
        for (int t = 0; t < nt; t += 2) {
            const bool last = (t == nt - 2);
            const char* a1 = cA + (size_t)(t + 1) * kstep;
            const char* a2 = last ? nA : cA + (size_t)(t + 2) * kstep; const char* b2 = last ? nB : cB + (size_t)(t + 2) * kstep;
            const char* a3 = a2 + kstep; const char* b3 = b2 + kstep;
            if (last && has_next) S.a_ready(nxt);
            if constexpr (Epi::MIDHOOK) { if (t == 8 || t == 16) E.mid(acc, cur, t >> 3, wr, wc, fr, fq); }
            if constexpr (SP2) {
            PG8_LDB(B0, 0, 0); PG8_LDB(B1, 0, 1); PG8_SCHED; PG8_LDA(At, 0, 0); PG8_STAGE(PG8_SA(1, 1), a1 + hstep, voffA);
            PG8_WAIT_V(8); PG8_WAIT_L(0); PG8_BAR; PG8_MMA(0, 0, At, B0); PG8_MMA(0, 1, At, B1); PG8_BAR; PG8_SCHED;
            PG8_LDA(At, 0, 1); PG8_STAGE(PG8_SB(0, 0), b2, voffB); PG8_STAGE(PG8_SB(0, 1), b2 + hstep, voffB); PG8_STAGE(PG8_SA(0, 0), a2, voffA);
            PG8_WAIT_V(8); PG8_WAIT_L(0); PG8_BAR; PG8_MMA(1, 0, At, B0); PG8_MMA(1, 1, At, B1); PG8_BAR; PG8_SCHED;
            PG8_LDB(B0, 1, 0); PG8_LDB(B1, 1, 1); PG8_SCHED; PG8_LDA(At, 1, 0); PG8_STAGE(PG8_SA(0, 1), a2 + hstep, voffA);
            PG8_WAIT_V(8); PG8_WAIT_L(0); PG8_BAR; PG8_MMA(0, 0, At, B0); PG8_MMA(0, 1, At, B1); PG8_BAR; PG8_SCHED;
            PG8_LDA(At, 1, 1); PG8_STAGE(PG8_SB(1, 0), b3, voffB); PG8_STAGE(PG8_SB(1, 1), b3 + hstep, voffB); PG8_STAGE(PG8_SA(1, 0), a3, voffA);
            PG8_WAIT_V(8); PG8_WAIT_L(0); PG8_BAR; PG8_MMA(1, 0, At, B0); PG8_MMA(1, 1, At, B1); PG8_BAR; PG8_SCHED;
            } else {
            PG8_LDB(B0, 0, 0); PG8_SCHED; PG8_LDA(At, 0, 0); PG8_STAGE(PG8_SA(1, 1), a1 + hstep, voffA);
            PG8_WAIT_L(8); PG8_BAR; PG8_WAIT_L(0); PG8_MMA(0, 0, At, B0); PG8_BAR; PG8_SCHED;
            PG8_LDB(B1, 0, 1); PG8_STAGE(PG8_SB(0, 0), b2, voffB);
            PG8_BAR; PG8_WAIT_L(0); PG8_MMA(0, 1, At, B1); PG8_BAR;
            PG8_LDA(At, 0, 1); PG8_STAGE(PG8_SA(0, 0), a2, voffA);
            PG8_BAR; PG8_WAIT_L(0); PG8_MMA(1, 0, At, B0); PG8_BAR; PG8_SCHED;
            PG8_STAGE(PG8_SB(0, 1), b2 + hstep, voffB);
            PG8_WAIT_V(6); PG8_BAR; PG8_MMA(1, 1, At, B1); PG8_BAR;
            PG8_LDB(B0, 1, 0); PG8_SCHED; PG8_LDA(At, 1, 0); PG8_STAGE(PG8_SA(0, 1), a2 + hstep, voffA);
            PG8_WAIT_L(8); PG8_BAR; PG8_WAIT_L(0); PG8_MMA(0, 0, At, B0); PG8_BAR; PG8_SCHED;
            PG8_LDB(B1, 1, 1); PG8_STAGE(PG8_SB(1, 0), b3, voffB);
            PG8_BAR; PG8_WAIT_L(0); PG8_MMA(0, 1, At, B1); PG8_BAR;
            PG8_LDA(At, 1, 1); PG8_STAGE(PG8_SA(1, 0), a3, voffA);
            PG8_BAR; PG8_WAIT_L(0); PG8_MMA(1, 0, At, B0); PG8_BAR; PG8_SCHED;
            PG8_STAGE(PG8_SB(1, 1), b3 + hstep, voffB);
            PG8_WAIT_V(6); PG8_BAR; PG8_MMA(1, 1, At, B1); PG8_BAR;
            }
        }
        if constexpr (ALIGN_EPI) { if (wr == 0) PG8_BAR; }
        E(acc, cur, wr, wc, fr, fq); S.done(cur);
        if (!has_next) break;
#pragma unroll
        for (int a = 0; a < 2; ++a)
#pragma unroll
            for (int b = 0; b < 2; ++b)
#pragma unroll
                for (int m = 0; m < 4; ++m)
#pragma unroll
                    for (int n = 0; n < 2; ++n) acc[a][b][m][n] = (f32x4){0.f, 0.f, 0.f, 0.f};
        cur = nxt; cA = nA; cB = nB; ++ui;
        if constexpr (ALIGN_EPI) { if (wr == 1) PG8_BAR; }
    }
    PG8_WAIT_V(0);
    if constexpr (!ALIGN_EPI) { if (wr == 0) PG8_BAR; }
    PG8_BAR;
#undef PG8_SA
#undef PG8_SB
#undef PG8_STAGE
#undef PG8_LDA
#undef PG8_LDB
#undef PG8_MMA
#undef PG8_WAIT_V
#undef PG8_WAIT_L
#undef PG8_BAR
#undef PG8_SCHED
}

__device__ __forceinline__ float fast_sigmoid(float v) { return __builtin_amdgcn_rcpf(1.0f + __builtin_amdgcn_exp2f(-v * LOG2E)); }

struct EpiProj {
    static constexpr bool PERM = true, MIDHOOK = false;
    bf16_t* P; const float* ssq; const float* qkg; float* kmean;
    __device__ __forceinline__ void operator()(const f32x4 (&acc)[2][2][4][2], const Unit& u, int wr, int wc, int fr, int fq) const {
        const int hh = 4 * u.pn + wc;
        int type, gi = 0;
        if (hh < 8) { type = 0; gi = 0; } else if (hh < 16) { type = 1; gi = 1; } else if (hh < 24) type = 2; else if (hh < 32) type = 3;
        else if (hh < 56) { type = 0; gi = 2; } else if (hh < 80) { type = 1; gi = 3; } else if (hh < 104) type = 2; else if (hh < 112) type = 3;
        else if (hh < 120) { type = 0; gi = 4; } else if (hh < 122) { type = 1; gi = 5; } else if (hh < 124) type = 2; else if (hh < 132) type = 3; else type = 4;
        const bool is_ka = (hh >= 8 && hh < 16);
        f32x4 gn[2][2];
#pragma unroll
        for (int bj = 0; bj < 2; ++bj)
#pragma unroll
            for (int n = 0; n < 2; ++n) gn[bj][n] = (type <= 1) ? *(const f32x4*)(qkg + gi * 64 + 32 * bj + 8 * fq + 4 * n) : (f32x4){1.f, 1.f, 1.f, 1.f};
        f32x4 cs[2][2];
#pragma unroll
        for (int bj = 0; bj < 2; ++bj)
#pragma unroll
            for (int n = 0; n < 2; ++n) cs[bj][n] = (f32x4){0.f, 0.f, 0.f, 0.f};
#pragma unroll
        for (int ai = 0; ai < 2; ++ai)
#pragma unroll
            for (int m = 0; m < 4; ++m) {
                const int row = u.pm * BM + ai * HALF + wr * 64 + m * 16 + fr;
                const f32x4 p4 = *(const f32x4*)(ssq + (size_t)row * 16 + 4 * fq);
                float s = (p4[0] + p4[1]) + (p4[2] + p4[3]); s += __shfl_xor(s, 16); s += __shfl_xor(s, 32);
                const float rs = 1.0f / sqrtf(s * (1.0f / DM) + EPS);
                f32x4 v[2][2];
#pragma unroll
                for (int bj = 0; bj < 2; ++bj)
#pragma unroll
                    for (int n = 0; n < 2; ++n) v[bj][n] = acc[ai][bj][m][n] * rs;
                if (type <= 1) {
                    float q = 0.f;
#pragma unroll
                    for (int bj = 0; bj < 2; ++bj)
#pragma unroll
                        for (int n = 0; n < 2; ++n) { const f32x4 x = v[bj][n]; q += (x[0] * x[0] + x[1] * x[1]) + (x[2] * x[2] + x[3] * x[3]); }
                    q += __shfl_xor(q, 16); q += __shfl_xor(q, 32);
                    float rn = 1.0f / sqrtf(q * (1.0f / HD) + EPS); if (type == 0) rn *= C2;
#pragma unroll
                    for (int bj = 0; bj < 2; ++bj)
#pragma unroll
                        for (int n = 0; n < 2; ++n) { v[bj][n] = v[bj][n] * rn * gn[bj][n]; cs[bj][n] += v[bj][n]; }
                } else if (type == 3) {
#pragma unroll
                    for (int bj = 0; bj < 2; ++bj)
#pragma unroll
                        for (int n = 0; n < 2; ++n)
#pragma unroll
                            for (int e = 0; e < 4; ++e) v[bj][n][e] = v[bj][n][e] * fast_sigmoid(v[bj][n][e]);
                } else if (type == 4) {
#pragma unroll
                    for (int bj = 0; bj < 2; ++bj)
#pragma unroll
                        for (int n = 0; n < 2; ++n)
#pragma unroll
                            for (int e = 0; e < 4; ++e) v[bj][n][e] = fast_sigmoid(v[bj][n][e]);
                }
                bf16_t* rowp = P + (size_t)row * CIN + hh * 64 + 8 * fq;
#pragma unroll
                for (int bj = 0; bj < 2; ++bj) { u32x4 w; w.x = cvt_pk_bf16(v[bj][0][0], v[bj][0][1]); w.y = cvt_pk_bf16(v[bj][0][2], v[bj][0][3]); w.z = cvt_pk_bf16(v[bj][1][0], v[bj][1][1]); w.w = cvt_pk_bf16(v[bj][1][2], v[bj][1][3]);
                    *(u32x4*)(rowp + 32 * bj) = w; }
                asm volatile("" ::: "memory");
            }
        if (is_ka) {
#pragma unroll
            for (int bj = 0; bj < 2; ++bj)
#pragma unroll
                for (int n = 0; n < 2; ++n)
#pragma unroll
                    for (int e = 0; e < 4; ++e) { float c = cs[bj][n][e]; c += __shfl_xor(c, 1); c += __shfl_xor(c, 2); c += __shfl_xor(c, 4); c += __shfl_xor(c, 8); cs[bj][n][e] = c; }
            if (fr == 0) {
                float* kp = kmean + ((size_t)(wr * 64 + u.pm) * 8 + (hh - 8)) * 64 + 8 * fq;
#pragma unroll
                for (int bj = 0; bj < 2; ++bj)
#pragma unroll
                    for (int n = 0; n < 2; ++n) *(f32x4*)(kp + 32 * bj + 4 * n) = cs[bj][n];
            }
        }
    }
};

struct EpiMerge {
    static constexpr bool PERM = true, MIDHOOK = true;
    const bf16_t* P; bf16_t* MG;
    __device__ __forceinline__ void mid(f32x4 (&acc)[2][2][4][2], const Unit& u, int seg, int wr, int wc, int fr, int fq) const {
        asm volatile("" : "+v"(fr), "+v"(fq));
#pragma unroll
        for (int ai = 0; ai < 2; ++ai)
#pragma unroll
            for (int m = 0; m < 4; ++m) {
                const int row = u.pm * BM + ai * HALF + wr * 64 + m * 16 + fr;
                const bf16_t* gp = P + (size_t)row * CIN + C_GL + (seg - 1) * DM + u.pn * BM + wc * 32 + 8 * fq;
#pragma unroll
                for (int bj = 0; bj < 2; ++bj) {
                    const u32x4 ga = *(const u32x4*)(gp + bj * HALF), gb = *(const u32x4*)(gp + DM + bj * HALF);
                    f32x4 r0, r1;
                    r0[0] = bf_lo(ga.x) * __builtin_amdgcn_rcpf(fmaxf(bf_lo(gb.x), 1e-30f)); r0[1] = bf_hi(ga.x) * __builtin_amdgcn_rcpf(fmaxf(bf_hi(gb.x), 1e-30f));
                    r0[2] = bf_lo(ga.y) * __builtin_amdgcn_rcpf(fmaxf(bf_lo(gb.y), 1e-30f)); r0[3] = bf_hi(ga.y) * __builtin_amdgcn_rcpf(fmaxf(bf_hi(gb.y), 1e-30f));
                    r1[0] = bf_lo(ga.z) * __builtin_amdgcn_rcpf(fmaxf(bf_lo(gb.z), 1e-30f)); r1[1] = bf_hi(ga.z) * __builtin_amdgcn_rcpf(fmaxf(bf_hi(gb.z), 1e-30f));
                    r1[2] = bf_lo(ga.w) * __builtin_amdgcn_rcpf(fmaxf(bf_lo(gb.w), 1e-30f)); r1[3] = bf_hi(ga.w) * __builtin_amdgcn_rcpf(fmaxf(bf_hi(gb.w), 1e-30f));
                    acc[ai][bj][m][0] *= r0; acc[ai][bj][m][1] *= r1;
                }
                asm volatile("" ::: "memory");
            }
    }
    __device__ __forceinline__ void operator()(const f32x4 (&acc)[2][2][4][2], const Unit& u, int wr, int wc, int fr, int fq) const {
#pragma unroll
        for (int ai = 0; ai < 2; ++ai)
#pragma unroll
            for (int m = 0; m < 4; ++m) {
                const int row = u.pm * BM + ai * HALF + wr * 64 + m * 16 + fr;
                const int col = u.pn * BM + wc * 32 + 8 * fq;
                const bf16_t* gp = P + (size_t)row * CIN + C_GL + 2 * DM + col;
#pragma unroll
                for (int bj = 0; bj < 2; ++bj) {
                    const u32x4 g = *(const u32x4*)(gp + bj * HALF);
                    const f32x4 a0 = acc[ai][bj][m][0], a1 = acc[ai][bj][m][1];
                    u32x4 w; w.x = cvt_pk_bf16(a0[0] * bf_lo(g.x), a0[1] * bf_hi(g.x)); w.y = cvt_pk_bf16(a0[2] * bf_lo(g.y), a0[3] * bf_hi(g.y));
                    w.z = cvt_pk_bf16(a1[0] * bf_lo(g.z), a1[1] * bf_hi(g.z)); w.w = cvt_pk_bf16(a1[2] * bf_lo(g.w), a1[3] * bf_hi(g.w));
                    *(u32x4*)(MG + (size_t)row * DM + col + bj * HALF) = w;
                }
                asm volatile("" ::: "memory");
            }
    }
};

struct EpiRes {
    static constexpr bool PERM = false, MIDHOOK = false;
    const float* xold; float* xout; bf16_t* XB; float* ssq;
    __device__ __forceinline__ void operator()(const f32x4 (&acc)[2][2][4][2], const Unit& u, int wr, int wc, int fr, int fq) const {
#pragma unroll
        for (int ai = 0; ai < 2; ++ai)
#pragma unroll
            for (int m = 0; m < 4; ++m) {
                const int row = u.pm * BM + ai * HALF + wr * 64 + m * 16 + fr;
                const size_t off = (size_t)row * DM + u.pn * BM + wc * 32 + 4 * fq;
                float ss = 0.f;
#pragma unroll
                for (int bj = 0; bj < 2; ++bj)
#pragma unroll
                    for (int n = 0; n < 2; ++n) {
                        const size_t o = off + bj * HALF + n * 16;
                        const f32x4 x = *(const f32x4*)(xold + o) + acc[ai][bj][m][n];
                        *(f32x4*)(xout + o) = x;
                        u32x2 w; w.x = cvt_pk_bf16(x[0], x[1]); w.y = cvt_pk_bf16(x[2], x[3]); *(u32x2*)(XB + o) = w;
                        ss += (x[0] * x[0] + x[1] * x[1]) + (x[2] * x[2] + x[3] * x[3]);
                    }
                ss += __shfl_xor(ss, 16); ss += __shfl_xor(ss, 32);
                if (fq == 0) ssq[(size_t)row * 16 + u.pn * 4 + wc] = ss;
                asm volatile("" ::: "memory");
            }
    }
};
}

constexpr int NWAVES = 8;
constexpr int N_PHASES = 1 + 4 * DEPTH;
constexpr size_t MiB = 1u << 20;
constexpr size_t WS_CTL = 0, CTL_ZERO_BYTES = 1 * MiB;
constexpr size_t WS_WIN = 1 * MiB;
constexpr size_t WS_WBR = WS_WIN + (size_t)DEPTH * CIN * DM * 2;
constexpr size_t WS_WOUT = WS_WBR + (size_t)DEPTH * DM * BRP * 2;
constexpr size_t WS_P = WS_WOUT + (size_t)DEPTH * DM * DM * 2;
constexpr size_t WS_BR = WS_P + (size_t)M * CIN * 2;
constexpr size_t WS_MG = WS_BR + (size_t)M * BRP * 2;
constexpr size_t WS_XB = WS_MG + (size_t)M * DM * 2;
constexpr size_t WS_OG = WS_XB + (size_t)M * DM * 2;
constexpr size_t WS_LSE = WS_OG + (size_t)3 * M * WBR * 2;
constexpr size_t WS_SSQ = WS_LSE + (size_t)3 * M * 8 * 4;
constexpr size_t WS_KM = WS_SSQ + (size_t)M * 16 * 4;
constexpr size_t WS_BIAS = WS_KM + (size_t)2 * 64 * 8 * 64 * 4;
constexpr size_t WS_QKG = WS_BIAS + (size_t)NH_TOT * SEQ * 4;
constexpr size_t WS_SINK = WS_QKG + (size_t)DEPTH * 6 * HD * 4;
constexpr size_t WS_END = WS_SINK + 4096;
constexpr int CW_BAR = 4096;

constexpr int RING_OFF = 0, RING_BYTES = 131072;
constexpr int LDSCTL_OFF = RING_BYTES, MISC_OFF = LDSCTL_OFF + 320;
constexpr int LDS_BYTES = 147456;
constexpr int VSTR = 144;
constexpr int AT_VT = 0, AT_VT_WAVE = 32 * VSTR;
constexpr int AT_TAB = 40960;
constexpr int AT_KM = AT_TAB + 2080 * 4;
static_assert(AT_VT + NWAVES * AT_VT_WAVE <= AT_TAB && AT_KM + 8 * 64 * 4 <= RING_BYTES, "attention LDS map");

#define GAS __attribute__((address_space(1)))
#define LAS __attribute__((address_space(3)))
typedef unsigned short bf16;
typedef unsigned v4u __attribute__((ext_vector_type(4)));
typedef unsigned v2u __attribute__((ext_vector_type(2)));
typedef float f32x4 __attribute__((ext_vector_type(4)));
typedef float f32x16 __attribute__((ext_vector_type(16)));
typedef short bf16x8 __attribute__((ext_vector_type(8)));
typedef short s16x4 __attribute__((ext_vector_type(4)));
typedef GAS unsigned gu32;
#define RLX_AGENT __ATOMIC_RELAXED, __HIP_MEMORY_SCOPE_AGENT
#define LDS_WAIT() asm volatile("s_waitcnt lgkmcnt(0)" ::: "memory")
#define VM_WAIT() asm volatile("s_waitcnt vmcnt(0)" ::: "memory")
using pg8::cvt_pk_bf16; using pg8::bf_lo; using pg8::bf_hi;

#define XB_TMO      128
#define XB_XCNT(j)  (256  + 64 * (j))
#define XB_XSUB(j)  (1280 + 64 * (j))
#define XB_XGEN(j)  (2304 + 64 * (j))
#define XB_TOP      3328
#define XB_TOPGEN   3392
#define XCD_BAR_WORDS 3456
#define XB_SPIN_CAP (1u << 18)
__device__ __forceinline__ unsigned xb_ld(unsigned* p)              { return __hip_atomic_load(p, __ATOMIC_RELAXED, __HIP_MEMORY_SCOPE_AGENT); }
__device__ __forceinline__ unsigned xb_add(unsigned* p, unsigned v) { return __hip_atomic_fetch_add(p, v, __ATOMIC_RELAXED, __HIP_MEMORY_SCOPE_AGENT); }
__device__ __forceinline__ unsigned xb_xcc_id() { return (unsigned)__builtin_amdgcn_s_getreg((3 << 11) | 20) & 0xFu; }
#define XB_SPIN(cond, bar) do { unsigned _sp = 0; while (cond) { __builtin_amdgcn_s_sleep(1); \
    if ((++_sp & 255u) == 0u) { if (xb_ld(&(bar)[XB_TMO])) break; if (_sp > XB_SPIN_CAP) { atomicAdd(&(bar)[XB_TMO], 1u); break; } } } } while (0)
struct XcdBarrier { unsigned* bar; unsigned x; volatile LAS unsigned* st; };
__device__ __forceinline__ XcdBarrier xcd_barrier_post(unsigned* bar, volatile LAS unsigned* st) {
    XcdBarrier b; b.bar = bar; b.x = xb_xcc_id(); b.st = st;
    if (threadIdx.x == 0) (void)xb_add(&bar[XB_XCNT(b.x)], 1u);
    return b;
}
__device__ __forceinline__ void xcd_barrier_complete(unsigned* bar, unsigned x, unsigned& nloc, unsigned& nx) {
    const unsigned G = gridDim.x * gridDim.y * gridDim.z;
    unsigned sum, cnt, mine, sp = 0u;
    for (;;) {
        sum = 0u; cnt = 0u; mine = 0u;
#pragma unroll
        for (unsigned j = 0; j < 16; ++j) { const unsigned c = xb_ld(&bar[XB_XCNT(j)]); sum += c; cnt += (c > 0u) ? 1u : 0u; mine = (j == x) ? c : mine; }
        if (sum == G) break;
        __builtin_amdgcn_s_sleep(1);
        if ((++sp & 255u) == 0u) { if (xb_ld(&bar[XB_TMO])) break; if (sp > XB_SPIN_CAP) { atomicAdd(&bar[XB_TMO], 1u); break; } }
    }
    nloc = mine > 0u ? mine : 1u; nx = cnt > 0u ? cnt : 1u;
}
__device__ __forceinline__ void xcd_barrier(const XcdBarrier& b) {
    asm volatile("s_waitcnt vmcnt(0)" ::: "memory");
    __syncthreads();
    if (threadIdx.x == 0) {
        unsigned* bar = b.bar;
        __builtin_amdgcn_s_waitcnt(0);
        unsigned nloc = b.st[0], nx = b.st[1];
        if (nloc == 0u) { xcd_barrier_complete(bar, b.x, nloc, nx); b.st[0] = nloc; b.st[1] = nx; }
        const unsigned old = xb_add(&bar[XB_XSUB(b.x)], 1u);
        const unsigned gen = old / nloc;
        if (old + 1u == (gen + 1u) * nloc) {
            __builtin_amdgcn_fence(__ATOMIC_RELEASE, "agent");
            asm volatile("s_waitcnt vmcnt(0)" ::: "memory");
            const unsigned og = xb_add(&bar[XB_TOP], 1u);
            const unsigned tg = og / nx;
            if (og + 1u == (tg + 1u) * nx) xb_add(&bar[XB_TOPGEN], 1u);
            else XB_SPIN(xb_ld(&bar[XB_TOPGEN]) == tg, bar);
            __builtin_amdgcn_fence(__ATOMIC_ACQUIRE, "agent");
            xb_add(&bar[XB_XGEN(b.x)], 1u);
            asm volatile("s_waitcnt vmcnt(0)" ::: "memory");
        } else {
            XB_SPIN(xb_ld(&bar[XB_XGEN(b.x)]) == gen, bar);
            __builtin_amdgcn_fence(__ATOMIC_ACQUIRE, "agent");
            asm volatile("s_waitcnt vmcnt(0)" ::: "memory");
        }
    }
    __syncthreads();
}

struct Frame {
    LAS unsigned char* lds;
    int tid, lane, wave, vcu, G;
    unsigned char* ws; const float* x; float* out;
};
#define F_WINT  ((bf16*)(F.ws + WS_WIN))
#define F_WBRT  ((bf16*)(F.ws + WS_WBR))
#define F_WOUTT ((bf16*)(F.ws + WS_WOUT))
#define F_P     ((bf16*)(F.ws + WS_P))
#define F_BR    ((bf16*)(F.ws + WS_BR))
#define F_MG    ((bf16*)(F.ws + WS_MG))
#define F_XB    ((bf16*)(F.ws + WS_XB))
#define F_OG    ((bf16*)(F.ws + WS_OG))
#define F_LSE   ((float*)(F.ws + WS_LSE))
#define F_SSQ   ((float*)(F.ws + WS_SSQ))
#define F_KM    ((float*)(F.ws + WS_KM))
#define F_BIAS  ((float*)(F.ws + WS_BIAS))
#define F_QKG   ((float*)(F.ws + WS_QKG))
#define F_SINK  ((float*)(F.ws + WS_SINK))

__device__ __forceinline__ void p0_transpose_item(const float* W, int ldw, int k0, int n0, bf16* WT, int ldt, int dst_row0, const float* kscale, LAS float* scr, int lane) {
#pragma unroll 8
    for (int i = 0; i < 32; ++i) { const int kk = 2 * i + (lane >> 5); float v = W[(size_t)(k0 + kk) * ldw + n0 + (lane & 31)]; if (kscale) v *= kscale[k0 + kk]; scr[kk * 33 + (lane & 31)] = v; }
    LDS_WAIT(); asm volatile("" ::: "memory");
    const int c = lane & 7;
#pragma unroll
    for (int j = 0; j < 4; ++j) { const int n = (lane >> 3) + 8 * j; const LAS float* s = scr + (8 * c) * 33 + n;
        v4u o; o.x = cvt_pk_bf16(s[0 * 33], s[1 * 33]); o.y = cvt_pk_bf16(s[2 * 33], s[3 * 33]); o.z = cvt_pk_bf16(s[4 * 33], s[5 * 33]); o.w = cvt_pk_bf16(s[6 * 33], s[7 * 33]);
        *(GAS v4u*)(WT + (size_t)(dst_row0 + n) * ldt + k0 + 8 * c) = o; }
    LDS_WAIT(); asm volatile("" ::: "memory");
}
__device__ __forceinline__ float wave_sum(float v) {
#pragma unroll
    for (int o = 1; o < 64; o <<= 1) v += __shfl_xor(v, o);
    return v;
}
__device__ __forceinline__ int rel_bucket_dev(int dist) {
    if (dist < 16) return dist;
    int b = 16;
    b += dist >= 22; b += dist >= 30; b += dist >= 40; b += dist >= 54; b += dist >= 73; b += dist >= 99; b += dist >= 134; b += dist >= 182;
    b += dist >= 246; b += dist >= 332; b += dist >= 450; b += dist >= 609; b += dist >= 825; b += dist >= 1117; b += dist >= 1513;
    return b;
}
__device__ __forceinline__ void p0_prologue(Frame& F0, const float* ln_g, const float* w_in, const float* qk_g, const float* sinks, const float* w_branch, const float* w_out, const float* rel_bias) {
    Frame F = F0; asm volatile("" : "+v"(F.tid), "+v"(F.lane));
    LAS float* scr = (LAS float*)(F.lds + RING_OFF + F.wave * 16384);
    const int gw = F.vcu * NWAVES + F.wave, NGW = F.G * NWAVES;
    constexpr int I_IN = (DM / 64) * (CIN / 32);
    constexpr int I_BR = (WBR / 64) * (DM / 32);
    constexpr int I_OUT = (DM / 64) * (DM / 32);
    constexpr int N_IN = DEPTH * I_IN, N_BR = DEPTH * 3 * I_BR, N_OUT = DEPTH * I_OUT, NITEMS = N_IN + N_BR + N_OUT;
    for (int it = gw; it < NITEMS; it += NGW) {
        int r = it;
        if (r < N_IN) {
            const int l = r / I_IN, q = r % I_IN, kb = q / (CIN / 32), nb = q % (CIN / 32);
            const int n0 = 32 * nb, pn = n0 >> 8, wc = (n0 >> 6) & 3, bj = (n0 >> 5) & 1, slot0 = 256 * pn + 128 * bj + 32 * wc;
            p0_transpose_item(w_in + (size_t)l * DM * CIN, CIN, 64 * kb, n0, F_WINT + (size_t)l * CIN * DM, DM, slot0, ln_g + l * DM, scr, F.lane);
            continue;
        }
        r -= N_IN;
        if (r < N_BR) {
            const int li = r / I_BR, q = r % I_BR, l = li / 3, i = li % 3, kb = q / (DM / 32), nb = q % (DM / 32);
            p0_transpose_item(w_branch + (size_t)li * WBR * DM, DM, 64 * kb, 32 * nb, F_WBRT + (size_t)l * DM * BRP + i * WBR, BRP, 32 * nb, nullptr, scr, F.lane);
            continue;
        }
        r -= N_BR;
        { const int l = r / I_OUT, q = r % I_OUT, kb = q / (DM / 32), nb = q % (DM / 32);
          p0_transpose_item(w_out + (size_t)l * DM * DM, DM, 64 * kb, 32 * nb, F_WOUTT + (size_t)l * DM * DM, DM, 32 * nb, nullptr, scr, F.lane); }
    }
    for (int m = gw; m < M; m += NGW) {
        const GAS f32x4* xr = (const GAS f32x4*)(F.x + (size_t)m * DM) + F.lane;
        GAS v2u* o8 = (GAS v2u*)(F_XB + (size_t)m * DM) + F.lane;
        float s = 0.f;
#pragma unroll
        for (int j = 0; j < 4; ++j) { const f32x4 v = xr[64 * j]; s += (v[0] * v[0] + v[1] * v[1]) + (v[2] * v[2] + v[3] * v[3]); v2u w; w.x = cvt_pk_bf16(v[0], v[1]); w.y = cvt_pk_bf16(v[2], v[3]); o8[64 * j] = w; }
        s = wave_sum(s);
        if (F.lane < 16) F_SSQ[(size_t)m * 16 + F.lane] = (F.lane == 0) ? s : 0.f;
    }
    for (int i = (F.vcu * NWAVES + F.wave) * 64 + F.lane; i < NH_TOT * SEQ; i += NGW * 64) { const int hd = i / SEQ, dist = i % SEQ; F_BIAS[i] = rel_bias[hd * NBUCK + rel_bucket_dev(dist)] * LOG2E; }
    if (F.vcu == 0) { for (int i = F.tid; i < DEPTH * 6 * HD; i += NWAVES * 64) F_QKG[i] = qk_g[i]; if (F.tid < DEPTH * 8) F_SINK[F.tid] = sinks[F.tid]; }
}

struct ATile {
    f32x16 o0, o1; float m, l;
    __device__ __forceinline__ void init() {
#pragma unroll
        for (int r = 0; r < 16; ++r) { o0[r] = 0.f; o1[r] = 0.f; }
        m = -1e30f; l = 0.f;
    }
};
__device__ __forceinline__ s16x4 vtr(const LAS unsigned char* p) { return __builtin_bit_cast(s16x4, __builtin_amdgcn_ds_read_tr16_b64_v4i16((LAS s16x4*)p)); }

__device__ __forceinline__ void at_load_k(bf16x8 (&kf)[4], const bf16* kcol, int krow, int hi) {
    const bf16* p = kcol + (size_t)krow * CIN + 8 * hi;
#pragma unroll
    for (int ks = 0; ks < 4; ++ks) kf[ks] = *(const bf16x8*)(p + 16 * ks);
}
__device__ __forceinline__ void at_softmax_pv(ATile& T, f32x16& s, const v4u (&vr)[4], LAS unsigned char* vt, int lane) {
#pragma unroll
    for (int i = 0; i < 4; ++i) *(LAS v4u*)(vt + ((lane >> 3) + 8 * i) * VSTR + (lane & 7) * 16) = vr[i];
    float mx = s[0];
#pragma unroll
    for (int r = 1; r < 16; ++r) mx = fmaxf(mx, s[r]);
    mx = fmaxf(mx, __shfl_xor(mx, 32));
    const float mn = fmaxf(T.m, mx);
    const float alpha = __builtin_amdgcn_exp2f(T.m - mn);
    T.m = mn;
    float ls = 0.f;
#pragma unroll
    for (int r = 0; r < 16; ++r) { s[r] = __builtin_amdgcn_exp2f(s[r] - mn); ls += s[r]; }
    T.l = T.l * alpha + ls;
#pragma unroll
    for (int r = 0; r < 16; ++r) { T.o0[r] *= alpha; T.o1[r] *= alpha; }
    v4u p0, p1;
    p0.x = cvt_pk_bf16(s[0], s[1]); p0.y = cvt_pk_bf16(s[2], s[3]); p0.z = cvt_pk_bf16(s[4], s[5]); p0.w = cvt_pk_bf16(s[6], s[7]);
    p1.x = cvt_pk_bf16(s[8], s[9]); p1.y = cvt_pk_bf16(s[10], s[11]); p1.z = cvt_pk_bf16(s[12], s[13]); p1.w = cvt_pk_bf16(s[14], s[15]);
    const bf16x8 pf0 = __builtin_bit_cast(bf16x8, p0), pf1 = __builtin_bit_cast(bf16x8, p1);
    asm volatile("" ::: "memory");
    const int hi = lane >> 5, dsub = (lane >> 4) & 1, q4 = (lane & 15) >> 2, p4 = lane & 3;
    const LAS unsigned char* vb = vt + (4 * hi + q4) * VSTR + (16 * dsub + 4 * p4) * 2;
#pragma unroll
    for (int dt = 0; dt < 2; ++dt) {
#pragma unroll
        for (int sidx = 0; sidx < 2; ++sidx) {
            const s16x4 lo = vtr(vb + (16 * sidx) * VSTR + dt * 64), hi4 = vtr(vb + (16 * sidx + 8) * VSTR + dt * 64);
            const bf16x8 vf = (bf16x8){lo[0], lo[1], lo[2], lo[3], hi4[0], hi4[1], hi4[2], hi4[3]};
            if (dt == 0) T.o0 = __builtin_amdgcn_mfma_f32_32x32x16_bf16(vf, sidx == 0 ? pf0 : pf1, T.o0, 0, 0, 0);
            else         T.o1 = __builtin_amdgcn_mfma_f32_32x32x16_bf16(vf, sidx == 0 ? pf0 : pf1, T.o1, 0, 0, 0);
        }
    }
    asm volatile("" ::: "memory");
}
__device__ __forceinline__ f32x16 at_qk(const bf16x8 (&kf)[4], const bf16x8 (&qf)[4]) {
    f32x16 s;
#pragma unroll
    for (int r = 0; r < 16; ++r) s[r] = 0.f;
#pragma unroll
    for (int ks = 0; ks < 4; ++ks) s = __builtin_amdgcn_mfma_f32_32x32x16_bf16(kf[ks], qf[ks], s, 0, 0, 0);
    return s;
}
__device__ __forceinline__ void at_store_gated(const ATile& T, float scale, const bf16* gate_row, bf16* out_row, int hi) {
#pragma unroll
    for (int dt = 0; dt < 2; ++dt)
#pragma unroll
        for (int g4 = 0; g4 < 4; ++g4) {
            const int d = 32 * dt + 8 * g4 + 4 * hi;
            const v2u g = *(const v2u*)(gate_row + d);
            const f32x16& o = dt == 0 ? T.o0 : T.o1;
            v2u w; w.x = cvt_pk_bf16(o[4 * g4 + 0] * scale * bf_lo(g.x), o[4 * g4 + 1] * scale * bf_hi(g.x)); w.y = cvt_pk_bf16(o[4 * g4 + 2] * scale * bf_lo(g.y), o[4 * g4 + 3] * scale * bf_hi(g.y));
            *(v2u*)(out_row + d) = w;
        }
}

__device__ __forceinline__ void moba_unit(Frame& F, int b, int h, int qb) {
    LAS float* tab = (LAS float*)(F.lds + AT_TAB);
    LAS float* kml = (LAS float*)(F.lds + AT_KM);
    LAS unsigned char* vt = F.lds + AT_VT + F.wave * AT_VT_WAVE;
    const int lane = F.lane, qi = lane & 31, hi = lane >> 5;
    __syncthreads();
    for (int i = F.tid; i < 2080; i += NWAVES * 64) { const int dlt = 2047 - i; tab[i] = dlt >= 0 ? F_BIAS[(OFF_A + h) * SEQ + dlt] : -INFINITY; }
    for (int i = F.tid; i < qb * 64; i += NWAVES * 64) { const int kb = i >> 6, d = i & 63, pm = b * 8 + kb;
        kml[i] = F_KM[((size_t)(0 * 64 + pm) * 8 + h) * 64 + d] + F_KM[((size_t)(1 * 64 + pm) * 8 + h) * 64 + d]; }
    __syncthreads();
    const int tq0 = qb * 256 + 32 * F.wave, rowb = b * SEQ;
    const size_t qrow = (size_t)(rowb + tq0 + qi);
    bf16x8 qf[4];
#pragma unroll
    for (int ks = 0; ks < 4; ++ks) qf[ks] = *(const bf16x8*)(F_P + qrow * CIN + C_QA + h * 64 + 16 * ks + 8 * hi);
    unsigned selmask = (1u << qb) - 1u;
    if (qb > 3) {
        float gt[7];
#pragma unroll
        for (int kb = 0; kb < 7; ++kb) {
            float a = 0.f;
            if (kb < qb) {
#pragma unroll
                for (int ks = 0; ks < 4; ++ks)
#pragma unroll
                    for (int j = 0; j < 8; ++j) a += __builtin_bit_cast(float, ((unsigned)(unsigned short)qf[ks][j]) << 16) * kml[kb * 64 + 16 * ks + 8 * hi + j];
                a += __shfl_xor(a, 32);
            }
            gt[kb] = a;
        }
        selmask = 0u;
#pragma unroll
        for (int pick = 0; pick < 3; ++pick) {
            float best = -INFINITY; int bi = 0;
#pragma unroll
            for (int kb = 0; kb < 7; ++kb) { const bool ok = (kb < qb) && !((selmask >> kb) & 1u) && (gt[kb] > best); best = ok ? gt[kb] : best; bi = ok ? kb : bi; }
            selmask |= 1u << bi;
        }
    }
    ATile T; T.init();
    const bf16* kcol = F_P + C_KA + h * 64;
    const bf16* vcol = F_P + C_VA + h * 64;
    const int nblk = qb + 1;
    for (int kb = 0; kb < nblk; ++kb) {
        const bool own = (kb == qb);
        const bool sel = own || ((selmask >> kb) & 1u);
        if (!__any(sel)) continue;
        const float pen = sel ? 0.f : -INFINITY;
        const int ntile = own ? (F.wave + 1) : 8;
        for (int kt = 0; kt < ntile; ++kt) {
            const int tk0 = kb * 256 + 32 * kt;
            bf16x8 kf[4]; at_load_k(kf, kcol, rowb + tk0 + qi, hi);
            v4u vr[4];
#pragma unroll
            for (int i = 0; i < 4; ++i) vr[i] = *(const v4u*)(vcol + (size_t)(rowb + tk0 + (lane >> 3) + 8 * i) * CIN + (lane & 7) * 8);
            f32x16 s = at_qk(kf, qf);
            const int yb = 2047 - (tq0 + qi) + tk0 + 4 * hi;
#pragma unroll
            for (int r = 0; r < 16; ++r) s[r] = s[r] + tab[yb + (r & 3) + 8 * (r >> 2)] + pen;
            at_softmax_pv(T, s, vr, vt, lane);
        }
    }
    const float ltot = T.l + __shfl_xor(T.l, 32);
    at_store_gated(T, 1.0f / ltot, F_P + qrow * CIN + C_GA + h * 64, F_BR + qrow * BRP + 0 * WBR + h * 64, hi);
}

__device__ __forceinline__ void swa_unit(Frame& F, int b, int spn, int hq, const float* sinks_l) {
    LAS float* tab = (LAS float*)(F.lds + AT_TAB);
    LAS unsigned char* vt = F.lds + AT_VT + F.wave * AT_VT_WAVE;
    const int lane = F.lane, qi = lane & 31, hi = lane >> 5;
    __syncthreads();
    for (int i = F.tid; i < 192; i += NWAVES * 64) { const int dlt = 160 - i; tab[i] = (dlt >= 0 && dlt < 128) ? F_BIAS[(OFF_C + hq) * SEQ + dlt] : 0.f; }
    __syncthreads();
    const int tq0 = spn * 256 + 32 * F.wave, rowb = b * SEQ, kvh = hq >> 2;
    const size_t qrow = (size_t)(rowb + tq0 + qi);
    bf16x8 qf[4];
#pragma unroll
    for (int ks = 0; ks < 4; ++ks) qf[ks] = *(const bf16x8*)(F_P + qrow * CIN + C_QC + hq * 64 + 16 * ks + 8 * hi);
    const bf16* kcol = F_P + C_KC + kvh * 64;
    const bf16* vcol = F_P + C_VC + kvh * 64;
    const int tq = tq0 + qi; const unsigned lim = (unsigned)(tq < 127 ? tq : 127);
    ATile T; T.init();
    for (int kt = 0; kt < 5; ++kt) {
        const int tk0 = tq0 - 128 + 32 * kt;
        if (tk0 + 31 < 0) continue;
        int kr = tk0 + qi; kr = kr < 0 ? 0 : kr;
        bf16x8 kf[4]; at_load_k(kf, kcol, rowb + kr, hi);
        v4u vr[4];
#pragma unroll
        for (int i = 0; i < 4; ++i) { int vrw = tk0 + (lane >> 3) + 8 * i; vrw = vrw < 0 ? 0 : vrw; vr[i] = *(const v4u*)(vcol + (size_t)(rowb + vrw) * CIN + (lane & 7) * 8); }
        f32x16 s = at_qk(kf, qf);
        const int db = tq - tk0 - 4 * hi;
#pragma unroll
        for (int r = 0; r < 16; ++r) { const int c = (r & 3) + 8 * (r >> 2); const int dlt = db - c; s[r] = ((unsigned)dlt <= lim) ? s[r] + tab[(160 - db) + c] : -INFINITY; }
        at_softmax_pv(T, s, vr, vt, lane);
    }
    float ltot = T.l + __shfl_xor(T.l, 32);
    const float sk = sinks_l[hq] * LOG2E;
    const float mn = fmaxf(T.m, sk), a = __builtin_amdgcn_exp2f(T.m - mn);
    ltot = ltot * a + __builtin_amdgcn_exp2f(sk - mn);
    at_store_gated(T, a / ltot, F_P + qrow * CIN + C_GC + hq * 64, F_BR + qrow * BRP + 2 * WBR + hq * 64, hi);
}

__device__ __forceinline__ void dil_unit(Frame& F, int b, int h, int sp) {
    LAS float* tab = (LAS float*)(F.lds + AT_TAB);
    LAS unsigned char* vt = F.lds + AT_VT + F.wave * AT_VT_WAVE;
    const int lane = F.lane, qi = lane & 31, hi = lane >> 5, rowb = b * SEQ;
    __syncthreads();
    for (int i = F.tid; i < 3 * 192; i += NWAVES * 64) { const int g = i / 192, y = i % 192, dlt = 160 - y, dil = (g == 0) ? 1 : (g == 1 ? 4 : 16);
        tab[i] = (dlt >= 0 && dlt <= 128) ? F_BIAS[(OFF_B + g * 8 + h) * SEQ + (dil * dlt > 2047 ? 2047 : dil * dlt)] : 0.f; }
    __syncthreads();
    for (int g = 0; g < 3; ++g) {
        const int dil = (g == 0) ? 1 : (g == 1 ? 4 : 16);
        for (int t2 = 0; t2 < 2; ++t2) {
            const int tt = 2 * F.wave + t2;
            int res, pq0, nkt, pkb;
            if (g == 0)      { res = 0;       pq0 = 512 * sp + 32 * tt;       nkt = 5;      pkb = pq0 - 128; }
            else if (g == 1) { res = tt >> 2; pq0 = 128 * sp + 32 * (tt & 3); nkt = 5;      pkb = pq0 - 128; }
            else             { res = tt;      pq0 = 32 * sp;                  nkt = sp + 1; pkb = 0; }
            const int pq = pq0 + qi;
            const size_t qrow = (size_t)(rowb + dil * pq + res);
            bf16x8 qf[4];
#pragma unroll
            for (int ks = 0; ks < 4; ++ks) qf[ks] = *(const bf16x8*)(F_P + qrow * CIN + C_QB + g * 512 + h * 64 + 16 * ks + 8 * hi);
            const bf16* kcol = F_P + C_KB + g * 512 + h * 64;
            const bf16* vcol = F_P + C_VB + g * 512 + h * 64;
            const unsigned lim = (unsigned)(pq < 128 ? pq : 128);
            ATile T; T.init();
            for (int kt = 0; kt < nkt; ++kt) {
                const int pk0 = pkb + 32 * kt;
                if (pk0 + 31 < 0) continue;
                int kp = pk0 + qi; kp = kp < 0 ? 0 : kp;
                bf16x8 kf[4]; at_load_k(kf, kcol, rowb + dil * kp + res, hi);
                v4u vr[4];
#pragma unroll
                for (int i = 0; i < 4; ++i) { int vp = pk0 + (lane >> 3) + 8 * i; vp = vp < 0 ? 0 : vp; vr[i] = *(const v4u*)(vcol + (size_t)(rowb + dil * vp + res) * CIN + (lane & 7) * 8); }
                f32x16 s = at_qk(kf, qf);
                const int db = pq - pk0 - 4 * hi;
#pragma unroll
                for (int r = 0; r < 16; ++r) { const int c = (r & 3) + 8 * (r >> 2); const int dlt = db - c; s[r] = ((unsigned)dlt <= lim) ? s[r] + tab[g * 192 + (160 - db) + c] : -INFINITY; }
                at_softmax_pv(T, s, vr, vt, lane);
            }
            const float ltot = T.l + __shfl_xor(T.l, 32);
            const float inv = 1.0f / ltot;
            bf16* og = F_OG + ((size_t)g * M + qrow) * WBR + h * 64;
#pragma unroll
            for (int dt = 0; dt < 2; ++dt)
#pragma unroll
                for (int g4 = 0; g4 < 4; ++g4) { const f32x16& o = dt == 0 ? T.o0 : T.o1; v2u w; w.x = cvt_pk_bf16(o[4 * g4 + 0] * inv, o[4 * g4 + 1] * inv); w.y = cvt_pk_bf16(o[4 * g4 + 2] * inv, o[4 * g4 + 3] * inv);
                    *(v2u*)(og + 32 * dt + 8 * g4 + 4 * hi) = w; }
            if (hi == 0) F_LSE[((size_t)g * M + qrow) * 8 + h] = T.m + __builtin_amdgcn_logf(ltot);
        }
    }
    VM_WAIT(); __syncthreads();
    {
        const size_t row = (size_t)(rowb + 512 * sp + F.tid);
        const float l0 = F_LSE[((size_t)0 * M + row) * 8 + h], l1 = F_LSE[((size_t)1 * M + row) * 8 + h], l2 = F_LSE[((size_t)2 * M + row) * 8 + h];
        const float mx = fmaxf(l0, fmaxf(l1, l2));
        float w0 = __builtin_amdgcn_exp2f(l0 - mx), w1 = __builtin_amdgcn_exp2f(l1 - mx), w2 = __builtin_amdgcn_exp2f(l2 - mx);
        const float inv = 1.0f / (w0 + w1 + w2); w0 *= inv; w1 *= inv; w2 *= inv;
        const bf16* o0p = F_OG + ((size_t)0 * M + row) * WBR + h * 64; const bf16* o1p = F_OG + ((size_t)1 * M + row) * WBR + h * 64; const bf16* o2p = F_OG + ((size_t)2 * M + row) * WBR + h * 64;
        const bf16* gp = F_P + row * CIN + C_GB + h * 64; bf16* op = F_BR + row * BRP + 1 * WBR + h * 64;
#pragma unroll
        for (int c = 0; c < 8; ++c) {
            const v4u a = *(const v4u*)(o0p + 8 * c), bq = *(const v4u*)(o1p + 8 * c), cq = *(const v4u*)(o2p + 8 * c), gg = *(const v4u*)(gp + 8 * c);
            v4u w;
            w.x = cvt_pk_bf16((w0 * bf_lo(a.x) + w1 * bf_lo(bq.x) + w2 * bf_lo(cq.x)) * bf_lo(gg.x), (w0 * bf_hi(a.x) + w1 * bf_hi(bq.x) + w2 * bf_hi(cq.x)) * bf_hi(gg.x));
            w.y = cvt_pk_bf16((w0 * bf_lo(a.y) + w1 * bf_lo(bq.y) + w2 * bf_lo(cq.y)) * bf_lo(gg.y), (w0 * bf_hi(a.y) + w1 * bf_hi(bq.y) + w2 * bf_hi(cq.y)) * bf_hi(gg.y));
            w.z = cvt_pk_bf16((w0 * bf_lo(a.z) + w1 * bf_lo(bq.z) + w2 * bf_lo(cq.z)) * bf_lo(gg.z), (w0 * bf_hi(a.z) + w1 * bf_hi(bq.z) + w2 * bf_hi(cq.z)) * bf_hi(gg.z));
            w.w = cvt_pk_bf16((w0 * bf_lo(a.w) + w1 * bf_lo(bq.w) + w2 * bf_lo(cq.w)) * bf_lo(gg.w), (w0 * bf_hi(a.w) + w1 * bf_hi(bq.w) + w2 * bf_hi(cq.w)) * bf_hi(gg.w));
            *(v4u*)(op + 8 * c) = w;
        }
    }
}

__device__ __forceinline__ void attn_phase(Frame& F0, int layer) {
    Frame F = F0; asm volatile("" : "+v"(F.tid), "+v"(F.lane));
    for (int u = F.vcu; u < 256; u += F.G) { const int bh = u >> 2, pr = u & 3; moba_unit(F, bh >> 3, bh & 7, pr); moba_unit(F, bh >> 3, bh & 7, 7 - pr); }
    for (int u = F.vcu; u < 256; u += F.G) { const int bh = u >> 2, sp = u & 3; dil_unit(F, bh >> 3, bh & 7, sp); }
    for (int u = F.vcu; u < 512; u += F.G) { const int hq = u & 7, spn = (u >> 3) & 7, b = u >> 6; swa_unit(F, b, spn, hq, F_SINK + layer * 8); }
    __syncthreads();
}

struct Args { const float* in[8]; float* out; unsigned char* ws; int ph_lo, ph_hi; };
__global__ void __launch_bounds__(NWAVES * 64, 2) trunk_fwd(Args args) {
    extern __shared__ __attribute__((aligned(16))) unsigned char lds[];
    Frame F;
    F.lds = (LAS unsigned char*)lds;
    F.tid = threadIdx.x; F.lane = F.tid & 63; F.wave = __builtin_amdgcn_readfirstlane(F.tid >> 6);
    F.G = gridDim.x; { const int bx = blockIdx.x; F.vcu = (F.G % 8 == 0) ? (bx % 8) * (F.G / 8) + bx / 8 : bx; }
    unsigned char* ws = args.ws;
    F.x = args.in[0]; F.ws = ws;
    F.out = args.out;
    for (int u = F.tid; u < (LDS_BYTES - LDSCTL_OFF) / 4; u += NWAVES * 64) ((LAS unsigned*)(F.lds + LDSCTL_OFF))[u] = 0u;
    __syncthreads();
    XcdBarrier bar; bar.bar = (unsigned*)(ws + WS_CTL) + CW_BAR; bar.x = 0; bar.st = nullptr;
    if (!MK_PER_PHASE) bar = xcd_barrier_post((unsigned*)(ws + WS_CTL) + CW_BAR, (volatile LAS unsigned*)(F.lds + MISC_OFF) + 8);
    const int lo = args.ph_lo, hi = args.ph_hi;
#define IN(k) (lo <= (k) && (k) < hi)
#define SEAM(k) do { if (IN(k) && IN((k) + 1)) xcd_barrier(bar); } while (0)
    if (IN(0) && (DBG_PH & 1)) { p0_prologue(F, args.in[1], args.in[2], args.in[3], args.in[4], args.in[5], args.in[6], args.in[7]); SEAM(0); }
    for (int l = 0; l < DEPTH; ++l) {
        const int p1 = 1 + 4 * l;
        if (IN(p1) && (DBG_PH & 2)) {
            pg8::Gemm g{F_XB, F_WINT + (size_t)l * CIN * DM, M, CIN, DM}; pg8::StaticOrder S; S.init(M, CIN, F.G, (int)blockIdx.x);
            pg8::EpiProj E{F_P, F_SSQ, F_QKG + l * 6 * HD, F_KM};
            pg8::gemm_phase<pg8::EpiProj, pg8::StaticOrder, true, true>(F.lds + RING_OFF, g, S, E);
            SEAM(p1);
        }
        if (IN(p1 + 1) && (DBG_PH & 4)) { attn_phase(F, l); SEAM(p1 + 1); }
        if (IN(p1 + 2) && (DBG_PH & 8)) {
            pg8::Gemm g{F_BR, F_WBRT + (size_t)l * DM * BRP, M, DM, BRP}; pg8::StaticOrder S; S.init(M, DM, F.G, (int)blockIdx.x);
            pg8::EpiMerge E{F_P, F_MG};
            pg8::gemm_phase<pg8::EpiMerge, pg8::StaticOrder, true, true>(F.lds + RING_OFF, g, S, E);
            SEAM(p1 + 2);
        }
        if (IN(p1 + 3) && (DBG_PH & 16)) {
            pg8::Gemm g{F_MG, F_WOUTT + (size_t)l * DM * DM, M, DM, DM}; pg8::StaticOrder S; S.init(M, DM, F.G, (int)blockIdx.x);
            pg8::EpiRes E{l == 0 ? F.x : F.out, F.out, F_XB, F_SSQ};
            pg8::gemm_phase<pg8::EpiRes, pg8::StaticOrder, true, true>(F.lds + RING_OFF, g, S, E);
            if (l + 1 < DEPTH) SEAM(p1 + 3);
        }
    }
#undef IN
#undef SEAM
}

extern "C" void kernel_launch(void* const* d_in, const int* in_sizes, int n_in, void* d_out, int out_size, void* d_ws, size_t ws_size, hipStream_t stream) {
    static int grid = 0;
    if (grid == 0) {
        if (n_in != 8 || in_sizes[0] != M * DM || out_size != M * DM || ws_size < WS_END) { fprintf(stderr, "kernel_launch: unexpected shapes (n_in %d, in0 %d, out %d, ws %zu need %zu); nothing launched\n", n_in, n_in > 0 ? in_sizes[0] : -1, out_size, ws_size, (size_t)WS_END); grid = -1; return; }
        int dev = 0, cus = 0, per_cu = 0;
        if (hipGetDevice(&dev) != hipSuccess || hipDeviceGetAttribute(&cus, hipDeviceAttributeMultiprocessorCount, dev) != hipSuccess) { fprintf(stderr, "kernel_launch: device query failed\n"); grid = -1; return; }
        if (hipFuncSetAttribute((const void*)trunk_fwd, hipFuncAttributeMaxDynamicSharedMemorySize, LDS_BYTES) != hipSuccess) { fprintf(stderr, "kernel_launch: hipFuncSetAttribute failed\n"); grid = -1; return; }
        if (hipOccupancyMaxActiveBlocksPerMultiprocessor(&per_cu, (const void*)trunk_fwd, NWAVES * 64, LDS_BYTES) != hipSuccess || per_cu < 1) fprintf(stderr, "kernel_launch: note: occupancy query reports %d workgroups per CU\n", per_cu);
        (void)hipGetLastError();
        grid = cus;
    }
    if (grid < 0) return;
    if (hipMemsetAsync((char*)d_ws + WS_CTL, 0, CTL_ZERO_BYTES, stream) != hipSuccess) { fprintf(stderr, "kernel_launch: memset failed\n"); return; }
    Args a{};
    for (int i = 0; i < 8; ++i) a.in[i] = (const float*)d_in[i];
    a.out = (float*)d_out; a.ws = (unsigned char*)d_ws;
#if MK_PER_PHASE
    for (int p = 0; p < N_PHASES; ++p) { a.ph_lo = p; a.ph_hi = p + 1; hipLaunchKernelGGL(trunk_fwd, dim3(grid), dim3(NWAVES * 64), LDS_BYTES, stream, a); }
#else
    a.ph_lo = 0; a.ph_hi = N_PHASES;
    hipLaunchKernelGGL(trunk_fwd, dim3(grid), dim3(NWAVES * 64), LDS_BYTES, stream, a);
#endif
    const hipError_t le = hipPeekAtLastError();
    if (le != hipSuccess) fprintf(stderr, "kernel_launch: launch failed: %s\n", hipGetErrorName(le));
}
```

```cpp
#include <hip/hip_runtime.h>
#include <cstdio>
#include <cstdint>

#ifndef DBG_PH
#define DBG_PH 31
#endif
#ifndef DBG_TWICE
#define DBG_TWICE 0
#endif
#ifndef G1_STAGGER_TICKS
#define G1_STAGGER_TICKS 0
#endif
#ifndef MK_PER_PHASE
#define MK_PER_PHASE 0
#endif

constexpr int BATCH = 8, SEQ = 2048, DM = 1024, DEPTH = 4, HD = 64, WBR = 512;
constexpr int M = BATCH * SEQ;
constexpr int CIN = 11520;
constexpr int NBUCK = 32, NH_TOT = 40, OFF_A = 0, OFF_B = 8, OFF_C = 32;
constexpr int C_QA = 0, C_KA = 512, C_VA = 1024, C_GA = 1536, C_QB = 2048, C_KB = 3584, C_VB = 5120, C_GB = 6656, C_QC = 7168, C_KC = 7680, C_VC = 7808, C_GC = 7936, C_GL = 8448;
constexpr float LOG2E = 1.4426950408889634f;
constexpr float C2 = 0.125f * LOG2E;
constexpr float EPS = 1e-6f;
constexpr int NHEADS = 132;
constexpr size_t GL_OFF = (size_t)NHEADS * 16384 * 64;
constexpr int BRP = 3 * WBR;

namespace pg8 {
#define PG8_LAS __attribute__((address_space(3)))
typedef unsigned short bf16_t;
typedef short bf16x8 __attribute__((ext_vector_type(8)));
typedef float f32x4 __attribute__((ext_vector_type(4)));
typedef unsigned u32x4 __attribute__((ext_vector_type(4)));
typedef unsigned u32x2 __attribute__((ext_vector_type(2)));
constexpr int BM = 256, BK = 64, HALF = 128, HTB = HALF * BK * 2, STAGE_BYTES = 8 * HTB, NXCD = 8, WGM = 8;

__host__ __device__ __forceinline__ int lds_byte(int r, int c) { const int st = (r >> 4) * 2 + (c >> 5), rr = r & 15, cc = c & 31, ob = rr * 64 + cc * 2; return st * 1024 + (ob ^ (((ob >> 9) & 1) << 5)); }
__host__ __device__ __forceinline__ void stage_rc(int b, int& R, int& C) { const int st = b / 1024, sb = b % 1024, swz = sb ^ (((sb >> 9) & 1) << 5); R = (st >> 1) * 16 + swz / 64; C = (st & 1) * 32 + (swz % 64) / 2; }
__host__ __device__ __forceinline__ int perm32(int rho) { const int n = rho >> 4, i = rho & 15; return 8 * (i >> 2) + 4 * n + (i & 3); }

struct Unit { int pm, pn; };
struct Gemm { const bf16_t* A; const bf16_t* Bt; int M, N, K; };

struct StaticOrder {
    int nM, nN, nwg, G, c;
    __host__ __device__ void init(int M_, int N_, int G_, int c_) { nM = M_ / BM; nN = N_ / BM; nwg = nM * nN; G = G_; c = c_; }
    __host__ __device__ bool next(int i, Unit& u) const {
        const long L = (long)i * G + c; if (L >= nwg) return false;
        int wgid = (int)L; { const int q = nwg / NXCD, r = nwg % NXCD, xcd = wgid % NXCD, off = wgid / NXCD; wgid = (xcd < r ? xcd * (q + 1) : r * (q + 1) + (xcd - r) * q) + off; }
        const int nig = WGM * nN, gid = wgid / nig, fm = gid * WGM, gsz = (nM - fm) < WGM ? (nM - fm) : WGM;
        u.pm = fm + ((wgid % nig) % gsz); u.pn = (wgid % nig) / gsz; return true;
    }
    __device__ __forceinline__ void a_ready(const Unit&) const {}
    __device__ __forceinline__ void done(const Unit&) const {}
};

typedef float f32x2 __attribute__((ext_vector_type(2)));
typedef __bf16 bf16x2_t __attribute__((ext_vector_type(2)));
__device__ __forceinline__ unsigned cvt_pk_bf16(float lo, float hi) { f32x2 v = {lo, hi}; bf16x2_t b = __builtin_convertvector(v, bf16x2_t); return __builtin_bit_cast(unsigned, b); }
__device__ __forceinline__ float bf_lo(unsigned w) { return __builtin_bit_cast(float, w << 16); }
__device__ __forceinline__ float bf_hi(unsigned w) { return __builtin_bit_cast(float, w & 0xffff0000u); }

template <class Epi, class Sched, bool ALIGN_EPI = false, bool SP2 = false>
__device__ __forceinline__ void gemm_phase(PG8_LAS unsigned char* lds, const Gemm g, const Sched& S, const Epi& E) {
    int tid_ = threadIdx.x; asm volatile("" : "+v"(tid_));
    const int tid = tid_, wid = __builtin_amdgcn_readfirstlane(tid >> 6), lane = tid & 63, wr = wid >> 2, wc = wid & 3, fr = lane & 15, fq = lane >> 4;
    const int K = g.K, nt = K / BK;
    unsigned voffA[2], voffB[2];
#pragma unroll
    for (int i = 0; i < 2; ++i) { int R, C; stage_rc(tid * 16 + i * 8192, R, C); const int Rb = Epi::PERM ? ((R & ~31) + perm32(R & 31)) : R;
        voffA[i] = (unsigned)(R * K + C) * 2u; voffB[i] = (unsigned)(Rb * K + C) * 2u; }
    const size_t kstep = (size_t)(BK * 2);
    const size_t hstep = (size_t)HALF * K * 2;
    const size_t tstep = 2 * hstep;
    const unsigned ldsw = (unsigned)wid * 1024u;
    const int aoff = lds_byte(wr * 64 + fr, fq * 8), boff = lds_byte(wc * 32 + fr, fq * 8);
#define PG8_SA(b, h) (((b) * 2 + (h)) * HTB)
#define PG8_SB(b, h) ((4 + (b) * 2 + (h)) * HTB)
#define PG8_STAGE(bufoff, gbase, voff) do { _Pragma("unroll") for (int _i = 0; _i < 2; ++_i) \
        __builtin_amdgcn_global_load_lds((const unsigned*)((const char*)(gbase) + (voff)[_i]), (PG8_LAS unsigned*)(lds + (bufoff) + ldsw + _i * 8192), 16, 0, 0); } while (0)
#define PG8_LDA(dst, b, h) do { _Pragma("unroll") for (int m = 0; m < 4; ++m) _Pragma("unroll") for (int k = 0; k < 2; ++k) dst[m][k] = *(const PG8_LAS bf16x8*)(lds + PG8_SA(b, h) + aoff + m * 2048 + k * 1024); } while (0)
#define PG8_LDB(dst, b, h) do { _Pragma("unroll") for (int n = 0; n < 2; ++n) _Pragma("unroll") for (int k = 0; k < 2; ++k) dst[n][k] = *(const PG8_LAS bf16x8*)(lds + PG8_SB(b, h) + boff + n * 2048 + k * 1024); } while (0)
#define PG8_MMA(ai, bj, At, Bt) do { __builtin_amdgcn_s_setprio(1); _Pragma("unroll") for (int m = 0; m < 4; ++m) _Pragma("unroll") for (int n = 0; n < 2; ++n) _Pragma("unroll") for (int k = 0; k < 2; ++k) \
        acc[ai][bj][m][n] = __builtin_amdgcn_mfma_f32_16x16x32_bf16(Bt[n][k], At[m][k], acc[ai][bj][m][n], 0, 0, 0); __builtin_amdgcn_s_setprio(0); } while (0)
#define PG8_WAIT_V(n) asm volatile("s_waitcnt vmcnt(" #n ")" ::: "memory")
#define PG8_WAIT_L(n) asm volatile("s_waitcnt lgkmcnt(" #n ")" ::: "memory")
#define PG8_BAR __builtin_amdgcn_s_barrier()
#define PG8_SCHED __builtin_amdgcn_sched_barrier(0)
    Unit cur, nxt; int ui = 0;
    if (!S.next(0, cur)) return;
    f32x4 acc[2][2][4][2];
#pragma unroll
    for (int a = 0; a < 2; ++a)
#pragma unroll
        for (int b = 0; b < 2; ++b)
#pragma unroll
            for (int m = 0; m < 4; ++m)
#pragma unroll
                for (int n = 0; n < 2; ++n) acc[a][b][m][n] = (f32x4){0.f, 0.f, 0.f, 0.f};
    bf16x8 At[4][2], B0[2][2], B1[2][2];
    const char* cA = (const char*)g.A + (size_t)cur.pm * tstep; const char* cB = (const char*)g.Bt + (size_t)cur.pn * tstep;
    S.a_ready(cur);
    if constexpr (SP2) {
        PG8_STAGE(PG8_SB(0, 0), cB, voffB); PG8_STAGE(PG8_SB(0, 1), cB + hstep, voffB); PG8_STAGE(PG8_SA(0, 0), cA, voffA); PG8_STAGE(PG8_SA(0, 1), cA + hstep, voffA);
        if (wr == 1) PG8_BAR;
        PG8_WAIT_V(2); PG8_BAR;
        PG8_STAGE(PG8_SB(1, 0), cB + kstep, voffB); PG8_STAGE(PG8_SA(1, 0), cA + kstep, voffA); PG8_STAGE(PG8_SB(1, 1), cB + hstep + kstep, voffB);
        PG8_WAIT_V(6); PG8_BAR;
    } else {
        PG8_STAGE(PG8_SB(0, 0), cB, voffB); PG8_STAGE(PG8_SA(0, 0), cA, voffA); PG8_STAGE(PG8_SB(0, 1), cB + hstep, voffB); PG8_STAGE(PG8_SA(0, 1), cA + hstep, voffA);
        if (wr == 1) PG8_BAR;
        PG8_WAIT_V(4); PG8_BAR;
        PG8_STAGE(PG8_SB(1, 0), cB + kstep, voffB); PG8_STAGE(PG8_SA(1, 0), cA + kstep, voffA); PG8_STAGE(PG8_SB(1, 1), cB + hstep + kstep, voffB);
        PG8_WAIT_V(6); PG8_BAR;
    }
    for (;;) {
        const bool has_next = S.next(ui + 1, nxt);
        const char* nA = has_next ? (const char*)g.A + (size_t)nxt.pm * tstep : cA; const char* nB = has_next ? (const char*)g.Bt + (size_t)nxt.pn * tstep : cB;
        for (int t = 0; t < nt; t += 2) {
            const bool last = (t == nt - 2);
            const char* a1 = cA + (size_t)(t + 1) * kstep;
            const char* a2 = last ? nA : cA + (size_t)(t + 2) * kstep; const char* b2 = last ? nB : cB + (size_t)(t + 2) * kstep;
            const char* a3 = a2 + kstep; const char* b3 = b2 + kstep;
            if (last && has_next) S.a_ready(nxt);
            if constexpr (Epi::PREFETCH) E.prefetch(cur, t, tid, lds + STAGE_BYTES + 1024 + wid * 256);
            if constexpr (Epi::MIDHOOK) { if (t == 8 || t == 16) E.mid(acc, cur, t >> 3, wr, wc, fr, fq); }
            if constexpr (SP2) {
            PG8_LDB(B0, 0, 0); PG8_LDB(B1, 0, 1); PG8_SCHED; PG8_LDA(At, 0, 0); PG8_STAGE(PG8_SA(1, 1), a1 + hstep, voffA);
            PG8_WAIT_V(8); PG8_WAIT_L(0); PG8_BAR; PG8_MMA(0, 0, At, B0); PG8_MMA(0, 1, At, B1); PG8_BAR; PG8_SCHED;
            PG8_LDA(At, 0, 1); PG8_STAGE(PG8_SB(0, 0), b2, voffB); PG8_STAGE(PG8_SB(0, 1), b2 + hstep, voffB); PG8_STAGE(PG8_SA(0, 0), a2, voffA);
            PG8_WAIT_V(8); PG8_WAIT_L(0); PG8_BAR; PG8_MMA(1, 0, At, B0); PG8_MMA(1, 1, At, B1); PG8_BAR; PG8_SCHED;
            PG8_LDB(B0, 1, 0); PG8_LDB(B1, 1, 1); PG8_SCHED; PG8_LDA(At, 1, 0); PG8_STAGE(PG8_SA(0, 1), a2 + hstep, voffA);
            PG8_WAIT_V(8); PG8_WAIT_L(0); PG8_BAR; PG8_MMA(0, 0, At, B0); PG8_MMA(0, 1, At, B1); PG8_BAR; PG8_SCHED;
            PG8_LDA(At, 1, 1); PG8_STAGE(PG8_SB(1, 0), b3, voffB); PG8_STAGE(PG8_SB(1, 1), b3 + hstep, voffB); PG8_STAGE(PG8_SA(1, 0), a3, voffA);
            PG8_WAIT_V(8); PG8_WAIT_L(0); PG8_BAR; PG8_MMA(1, 0, At, B0); PG8_MMA(1, 1, At, B1); PG8_BAR; PG8_SCHED;
            } else {
            PG8_LDB(B0, 0, 0); PG8_SCHED; PG8_LDA(At, 0, 0); PG8_STAGE(PG8_SA(1, 1), a1 + hstep, voffA);
            PG8_WAIT_L(8); PG8_BAR; PG8_WAIT_L(0); PG8_MMA(0, 0, At, B0); PG8_BAR; PG8_SCHED;
            PG8_LDB(B1, 0, 1); PG8_STAGE(PG8_SB(0, 0), b2, voffB);
            PG8_BAR; PG8_WAIT_L(0); PG8_MMA(0, 1, At, B1); PG8_BAR;
            PG8_LDA(At, 0, 1); PG8_STAGE(PG8_SA(0, 0), a2, voffA);
            PG8_BAR; PG8_WAIT_L(0); PG8_MMA(1, 0, At, B0); PG8_BAR; PG8_SCHED;
            PG8_STAGE(PG8_SB(0, 1), b2 + hstep, voffB);
            PG8_WAIT_V(6); PG8_BAR; PG8_MMA(1, 1, At, B1); PG8_BAR;
            PG8_LDB(B0, 1, 0); PG8_SCHED; PG8_LDA(At, 1, 0); PG8_STAGE(PG8_SA(0, 1), a2 + hstep, voffA);
            PG8_WAIT_L(8); PG8_BAR; PG8_WAIT_L(0); PG8_MMA(0, 0, At, B0); PG8_BAR; PG8_SCHED;
            PG8_LDB(B1, 1, 1); PG8_STAGE(PG8_SB(1, 0), b3, voffB);
            PG8_BAR; PG8_WAIT_L(0); PG8_MMA(0, 1, At, B1); PG8_BAR;
            PG8_LDA(At, 1, 1); PG8_STAGE(PG8_SA(1, 0), a3, voffA);
            PG8_BAR; PG8_WAIT_L(0); PG8_MMA(1, 0, At, B0); PG8_BAR; PG8_SCHED;
            PG8_STAGE(PG8_SB(1, 1), b3 + hstep, voffB);
            PG8_WAIT_V(6); PG8_BAR; PG8_MMA(1, 1, At, B1); PG8_BAR;
            }
        }
        if constexpr (ALIGN_EPI) { if (wr == 0) PG8_BAR; }
        if constexpr (!Epi::AFTER_DRAIN) { E(acc, cur, wr, wc, fr, fq); S.done(cur); }
        if (!has_next) break;
#pragma unroll
        for (int a = 0; a < 2; ++a)
#pragma unroll
            for (int b = 0; b < 2; ++b)
#pragma unroll
                for (int m = 0; m < 4; ++m)
#pragma unroll
                    for (int n = 0; n < 2; ++n) acc[a][b][m][n] = (f32x4){0.f, 0.f, 0.f, 0.f};
        cur = nxt; cA = nA; cB = nB; ++ui;
        if constexpr (ALIGN_EPI) { if (wr == 1) PG8_BAR; }
    }
    PG8_WAIT_V(0);
    if constexpr (!ALIGN_EPI) { if (wr == 0) PG8_BAR; }
    PG8_BAR;
    if constexpr (Epi::AFTER_DRAIN) { E.fused(acc, cur, wr, wc, fr, fq, lds, wid, lane); S.done(cur); }
#undef PG8_SA
#undef PG8_SB
#undef PG8_STAGE
#undef PG8_LDA
#undef PG8_LDB
#undef PG8_MMA
#undef PG8_WAIT_V
#undef PG8_WAIT_L
#undef PG8_BAR
#undef PG8_SCHED
}

__device__ __forceinline__ void swap16(float x, float& a, float& b) { a = x; b = x; asm volatile("v_nop\n\tv_nop\n\tv_permlane16_swap_b32 %0, %1" : "+v"(a), "+v"(b)); }
__device__ __forceinline__ void swap32(float x, float& a, float& b) { a = x; b = x; asm volatile("v_nop\n\tv_nop\n\tv_permlane32_swap_b32 %0, %1" : "+v"(a), "+v"(b)); }
__device__ __forceinline__ float xrow16_sum(float x) {
    float a, b; swap16(x, a, b); x = a + b; swap32(x, a, b); return a + b;
}
__device__ __forceinline__ float xhalf_max(float x) { float a, b; swap32(x, a, b); return fmaxf(a, b); }
__device__ __forceinline__ float fast_sigmoid(float v) { return __builtin_amdgcn_rcpf(1.0f + __builtin_amdgcn_exp2f(-v * LOG2E)); }

template <bool STORE = true> struct EpiProjT {
    static constexpr bool PERM = true, MIDHOOK = false, PREFETCH = false, AFTER_DRAIN = false;
    bf16_t* P; const float* ssq; const float* qkg; float* kmean;
    __device__ __forceinline__ void operator()(const f32x4 (&acc)[2][2][4][2], const Unit& u, int wr, int wc, int fr, int fq) const {
        const int hh = 4 * u.pn + wc;
        int type, gi = 0;
        if (hh < 8) { type = 0; gi = 0; } else if (hh < 16) { type = 1; gi = 1; } else if (hh < 24) type = 2; else if (hh < 32) type = 3;
        else if (hh < 56) { type = 0; gi = 2; } else if (hh < 80) { type = 1; gi = 3; } else if (hh < 104) type = 2; else if (hh < 112) type = 3;
        else if (hh < 120) { type = 0; gi = 4; } else if (hh < 122) { type = 1; gi = 5; } else if (hh < 124) type = 2; else if (hh < 132) type = 3; else type = 4;
        const bool is_ka = (hh >= 8 && hh < 16);
        const int dsh = (hh >= 32 && hh < 104) ? 2 * (((hh - 32) % 24) >> 3) : 0;
        f32x4 gn[2][2];
#pragma unroll
        for (int bj = 0; bj < 2; ++bj)
#pragma unroll
            for (int n = 0; n < 2; ++n) gn[bj][n] = (type <= 1) ? *(const f32x4*)(qkg + gi * 64 + 32 * bj + 8 * fq + 4 * n) : (f32x4){1.f, 1.f, 1.f, 1.f};
        f32x4 cs[2][2];
#pragma unroll
        for (int bj = 0; bj < 2; ++bj)
#pragma unroll
            for (int n = 0; n < 2; ++n) cs[bj][n] = (f32x4){0.f, 0.f, 0.f, 0.f};
        float rsv[2][4];
        { f32x4 p4[2][4];
#pragma unroll
          for (int ai = 0; ai < 2; ++ai)
#pragma unroll
            for (int m = 0; m < 4; ++m) p4[ai][m] = *(const f32x4*)(ssq + (size_t)(u.pm * BM + ai * HALF + wr * 64 + m * 16 + fr) * 4);
#pragma unroll
          for (int ai = 0; ai < 2; ++ai)
#pragma unroll
            for (int m = 0; m < 4; ++m) rsv[ai][m] = 1.0f / sqrtf(((p4[ai][m][0] + p4[ai][m][1]) + (p4[ai][m][2] + p4[ai][m][3])) * (1.0f / DM) + EPS); }
#pragma unroll
        for (int ai = 0; ai < 2; ++ai)
#pragma unroll
            for (int m = 0; m < 4; ++m) {
                const int row = u.pm * BM + ai * HALF + wr * 64 + m * 16 + fr;
                const float rs = rsv[ai][m];
                f32x4 v[2][2];
#pragma unroll
                for (int bj = 0; bj < 2; ++bj)
#pragma unroll
                    for (int n = 0; n < 2; ++n) v[bj][n] = acc[ai][bj][m][n] * rs;
                if (type <= 1) {
                    float q = 0.f;
#pragma unroll
                    for (int bj = 0; bj < 2; ++bj)
#pragma unroll
                        for (int n = 0; n < 2; ++n) { const f32x4 x = v[bj][n]; q += (x[0] * x[0] + x[1] * x[1]) + (x[2] * x[2] + x[3] * x[3]); }
                    q = xrow16_sum(q);
                    float rn = 1.0f / sqrtf(q * (1.0f / HD) + EPS); if (type == 0) rn *= C2;
#pragma unroll
                    for (int bj = 0; bj < 2; ++bj)
#pragma unroll
                        for (int n = 0; n < 2; ++n) { v[bj][n] = v[bj][n] * rn * gn[bj][n]; cs[bj][n] += v[bj][n]; }
                } else if (type == 3) {
#pragma unroll
                    for (int bj = 0; bj < 2; ++bj)
#pragma unroll
                        for (int n = 0; n < 2; ++n)
#pragma unroll
                            for (int e = 0; e < 4; ++e) v[bj][n][e] = v[bj][n][e] * fast_sigmoid(v[bj][n][e]);
                } else if (type == 4) {
#pragma unroll
                    for (int bj = 0; bj < 2; ++bj)
#pragma unroll
                        for (int n = 0; n < 2; ++n)
#pragma unroll
                            for (int e = 0; e < 4; ++e) v[bj][n][e] = fast_sigmoid(v[bj][n][e]);
                }
                bf16_t* rowp;
                if (type == 4) rowp = P + GL_OFF + (size_t)row * 3072 + (hh - NHEADS) * 64 + 8 * fq;
                else { int ridx = row;
                    if (dsh) { const int t = row & (SEQ - 1); ridx = (row & ~(SEQ - 1)) + ((t & ((1 << dsh) - 1)) << (11 - dsh)) + (t >> dsh); }
                    rowp = P + ((size_t)hh * M + ridx) * HD + 8 * fq; }
#pragma unroll
                for (int bj = 0; bj < 2; ++bj) { u32x4 w; w.x = cvt_pk_bf16(v[bj][0][0], v[bj][0][1]); w.y = cvt_pk_bf16(v[bj][0][2], v[bj][0][3]); w.z = cvt_pk_bf16(v[bj][1][0], v[bj][1][1]); w.w = cvt_pk_bf16(v[bj][1][2], v[bj][1][3]);
                    if (STORE) *(u32x4*)(rowp + 32 * bj) = w; else asm volatile("" :: "v"(w), "v"(rowp)); }
            }
        if (is_ka) {
#pragma unroll
            for (int bj = 0; bj < 2; ++bj)
#pragma unroll
                for (int n = 0; n < 2; ++n)
#pragma unroll
                    for (int e = 0; e < 4; ++e) { float c = cs[bj][n][e]; c += __shfl_xor(c, 1); c += __shfl_xor(c, 2); c += __shfl_xor(c, 4); c += __shfl_xor(c, 8); cs[bj][n][e] = c; }
            if (fr == 0) {
                float* kp = kmean + ((size_t)(wr * 64 + u.pm) * 8 + (hh - 8)) * 64 + 8 * fq;
#pragma unroll
                for (int bj = 0; bj < 2; ++bj)
#pragma unroll
                    for (int n = 0; n < 2; ++n) *(f32x4*)(kp + 32 * bj + 4 * n) = cs[bj][n];
            }
        }
    }
};

struct EpiNull {
    static constexpr bool PERM = true, MIDHOOK = false, PREFETCH = false, AFTER_DRAIN = false;
    __device__ __forceinline__ void operator()(const f32x4 (&acc)[2][2][4][2], const Unit& u, int wr, int wc, int fr, int fq) const {
#pragma unroll
        for (int a = 0; a < 2; ++a)
#pragma unroll
            for (int b = 0; b < 2; ++b)
#pragma unroll
                for (int m = 0; m < 4; ++m)
#pragma unroll
                    for (int n = 0; n < 2; ++n) asm volatile("" :: "v"(acc[a][b][m][n]));
    }
};
typedef EpiProjT<true> EpiProj;
struct EpiMerge {
    static constexpr bool PERM = true, MIDHOOK = true, PREFETCH = false, AFTER_DRAIN = false;
    const bf16_t* P; bf16_t* MG;
    __device__ __forceinline__ void prefetch(const Unit& u, int t, int tid, PG8_LAS unsigned char* junk) const {
        if (t > 10) return;
        const int L = (t >> 1) * 512 + tid;
        const bf16_t* p = P + GL_OFF + (size_t)(u.pm * BM + ((L >> 2) & 255)) * 3072 + (L >> 10) * DM + u.pn * BM + (L & 3) * 64;
        __builtin_amdgcn_global_load_lds((const unsigned*)p, (PG8_LAS unsigned*)junk, 4, 0, 0);
    }
    __device__ __forceinline__ void mid(f32x4 (&acc)[2][2][4][2], const Unit& u, int seg, int wr, int wc, int fr, int fq) const {
        asm volatile("" : "+v"(fr), "+v"(fq));
#pragma unroll
        for (int ai = 0; ai < 2; ++ai)
#pragma unroll
            for (int m = 0; m < 4; ++m) {
                const int row = u.pm * BM + ai * HALF + wr * 64 + m * 16 + fr;
                const bf16_t* gp = P + GL_OFF + (size_t)row * 3072 + (seg - 1) * DM + u.pn * BM + wc * 32 + 8 * fq;
#pragma unroll
                for (int bj = 0; bj < 2; ++bj) {
                    const u32x4 ga = *(const u32x4*)(gp + bj * HALF), gb = *(const u32x4*)(gp + DM + bj * HALF);
                    f32x4 r0, r1;
                    r0[0] = bf_lo(ga.x) * __builtin_amdgcn_rcpf(fmaxf(bf_lo(gb.x), 1e-30f)); r0[1] = bf_hi(ga.x) * __builtin_amdgcn_rcpf(fmaxf(bf_hi(gb.x), 1e-30f));
                    r0[2] = bf_lo(ga.y) * __builtin_amdgcn_rcpf(fmaxf(bf_lo(gb.y), 1e-30f)); r0[3] = bf_hi(ga.y) * __builtin_amdgcn_rcpf(fmaxf(bf_hi(gb.y), 1e-30f));
                    r1[0] = bf_lo(ga.z) * __builtin_amdgcn_rcpf(fmaxf(bf_lo(gb.z), 1e-30f)); r1[1] = bf_hi(ga.z) * __builtin_amdgcn_rcpf(fmaxf(bf_hi(gb.z), 1e-30f));
                    r1[2] = bf_lo(ga.w) * __builtin_amdgcn_rcpf(fmaxf(bf_lo(gb.w), 1e-30f)); r1[3] = bf_hi(ga.w) * __builtin_amdgcn_rcpf(fmaxf(bf_hi(gb.w), 1e-30f));
                    acc[ai][bj][m][0] *= r0; acc[ai][bj][m][1] *= r1;
                }
                if (m == 3) asm volatile("" ::: "memory");
            }
    }
    __device__ __forceinline__ void operator()(const f32x4 (&acc)[2][2][4][2], const Unit& u, int wr, int wc, int fr, int fq) const {
#pragma unroll
        for (int ai = 0; ai < 2; ++ai)
#pragma unroll
            for (int m = 0; m < 4; ++m) {
                const int row = u.pm * BM + ai * HALF + wr * 64 + m * 16 + fr;
                const int col = u.pn * BM + wc * 32 + 8 * fq;
                const bf16_t* gp = P + GL_OFF + (size_t)row * 3072 + 2 * DM + col;
#pragma unroll
                for (int bj = 0; bj < 2; ++bj) {
                    const u32x4 g = *(const u32x4*)(gp + bj * HALF);
                    const f32x4 a0 = acc[ai][bj][m][0], a1 = acc[ai][bj][m][1];
                    u32x4 w; w.x = cvt_pk_bf16(a0[0] * bf_lo(g.x), a0[1] * bf_hi(g.x)); w.y = cvt_pk_bf16(a0[2] * bf_lo(g.y), a0[3] * bf_hi(g.y));
                    w.z = cvt_pk_bf16(a1[0] * bf_lo(g.z), a1[1] * bf_hi(g.z)); w.w = cvt_pk_bf16(a1[2] * bf_lo(g.w), a1[3] * bf_hi(g.w));
                    *(u32x4*)(MG + (size_t)row * DM + col + bj * HALF) = w;
                }
                if (m == 3) asm volatile("" ::: "memory");
            }
    }
};

struct EpiRes {
    static constexpr bool PERM = false, MIDHOOK = false, PREFETCH = false, AFTER_DRAIN = true;
    const float* xold; float* xout; bf16_t* XB; float* ssq;
    __device__ __forceinline__ void prefetch(const Unit& u, int t, int tid, PG8_LAS unsigned char* junk) const {
        if (tid >= 256) return;
        const int L = (t >> 1) * 256 + tid;
        const float* p = xold + (size_t)(u.pm * BM + (L >> 3)) * DM + u.pn * BM + (L & 7) * 32;
        __builtin_amdgcn_global_load_lds((const unsigned*)p, (PG8_LAS unsigned*)junk, 4, 0, 0);
    }
    __device__ __forceinline__ void fused(const f32x4 (&acc)[2][2][4][2], const Unit& u, int wr, int wc, int fr, int fq, PG8_LAS unsigned char* lds, int wid, int lane) const {
        PG8_LAS float* part = (PG8_LAS float*)lds;
#pragma unroll
        for (int ai = 0; ai < 2; ++ai)
#pragma unroll
            for (int m = 0; m < 4; ++m) {
                const int r = ai * HALF + wr * 64 + m * 16 + fr;
                const size_t off = (size_t)(u.pm * BM + r) * DM + u.pn * BM + wc * 32 + 4 * fq;
                float ss = 0.f;
#pragma unroll
                for (int bj = 0; bj < 2; ++bj)
#pragma unroll
                    for (int n = 0; n < 2; ++n) {
                        const size_t o = off + bj * HALF + n * 16;
                        const f32x4 x = *(const f32x4*)(xold + o) + acc[ai][bj][m][n];
                        *(f32x4*)(xout + o) = x;
                        u32x2 w; w.x = cvt_pk_bf16(x[0], x[1]); w.y = cvt_pk_bf16(x[2], x[3]); *(u32x2*)(XB + o) = w;
                        ss += (x[0] * x[0] + x[1] * x[1]) + (x[2] * x[2] + x[3] * x[3]);
                    }
                ss = xrow16_sum(ss);
                if (fq == 0) part[r * 4 + wc] = ss;
                if (m & 1) asm volatile("" ::: "memory");
            }
        asm volatile("s_waitcnt lgkmcnt(0)" ::: "memory"); __builtin_amdgcn_s_barrier(); asm volatile("" ::: "memory");
        const int tid = wid * 64 + lane;
        if (tid < 256) { const f32x4 p = *(const PG8_LAS f32x4*)(part + tid * 4); ssq[(size_t)(u.pm * BM + tid) * 4 + u.pn] = (p[0] + p[1]) + (p[2] + p[3]); }
    }
};
}

constexpr int NWAVES = 8;
constexpr int N_PHASES = 1 + 4 * DEPTH;
constexpr size_t MiB = 1u << 20;
constexpr size_t WS_CTL = 0, CTL_ZERO_BYTES = 1 * MiB;
constexpr size_t WS_WIN = 1 * MiB;
constexpr size_t WS_WBR = WS_WIN + (size_t)DEPTH * CIN * DM * 2;
constexpr size_t WS_WOUT = WS_WBR + (size_t)DEPTH * DM * BRP * 2;
constexpr size_t WS_P = WS_WOUT + (size_t)DEPTH * DM * DM * 2;
constexpr size_t WS_BR = WS_P + (size_t)M * CIN * 2;
constexpr size_t WS_MG = WS_BR + (size_t)M * BRP * 2;
constexpr size_t WS_XB = WS_MG + (size_t)M * DM * 2;
constexpr size_t WS_OG = WS_XB + (size_t)M * DM * 2;
constexpr size_t WS_LSE = WS_OG + (size_t)3 * M * WBR * 2;
constexpr size_t WS_SSQ = WS_LSE + (size_t)3 * M * 8 * 4;
constexpr size_t WS_KM = WS_SSQ + (size_t)M * 16 * 4;
constexpr size_t WS_BIAS = WS_KM + (size_t)2 * 64 * 8 * 64 * 4;
constexpr size_t WS_QKG = WS_BIAS + (size_t)NH_TOT * SEQ * 4;
constexpr size_t WS_SINK = WS_QKG + (size_t)DEPTH * 6 * HD * 4;
constexpr size_t WS_END = WS_SINK + 4096;
constexpr int CW_BAR = 4096;

constexpr int RING_OFF = 0, RING_BYTES = 131072;
constexpr int LDSCTL_OFF = RING_BYTES, MISC_OFF = LDSCTL_OFF + 320;
constexpr int LDS_BYTES = 147456;
constexpr int VSTR = 144;
constexpr int AT_VT = 0, AT_VT_WAVE = 32 * VSTR;
constexpr int AT_TAB = 40960;
constexpr int AT_KM = AT_TAB + 2080 * 4;
constexpr int AT_RING = AT_KM + 8 * 64 * 4;
constexpr int AT_KM2 = AT_TAB + 4 * 2128 * 4;
constexpr int AT_RING2 = AT_KM2 + 8 * 64 * 4;
static_assert(AT_VT + NWAVES * AT_VT_WAVE <= AT_TAB && AT_RING2 + 2 * 128 * VSTR <= RING_BYTES && AT_RING2 % 16 == 0 && AT_TAB % 16 == 0, "attention LDS map");

#define GAS __attribute__((address_space(1)))
#define LAS __attribute__((address_space(3)))
typedef unsigned short bf16;
typedef unsigned v4u __attribute__((ext_vector_type(4)));
typedef unsigned v2u __attribute__((ext_vector_type(2)));
typedef float f32x4 __attribute__((ext_vector_type(4)));
typedef float f32x16 __attribute__((ext_vector_type(16)));
typedef short bf16x8 __attribute__((ext_vector_type(8)));
typedef short s16x4 __attribute__((ext_vector_type(4)));
typedef GAS unsigned gu32;
#define RLX_AGENT __ATOMIC_RELAXED, __HIP_MEMORY_SCOPE_AGENT
#define LDS_WAIT() asm volatile("s_waitcnt lgkmcnt(0)" ::: "memory")
#define VM_WAIT() asm volatile("s_waitcnt vmcnt(0)" ::: "memory")
using pg8::cvt_pk_bf16; using pg8::bf_lo; using pg8::bf_hi;

#define XB_TMO      128
#define XB_XCNT(j)  (256  + 64 * (j))
#define XB_XSUB(j)  (1280 + 64 * (j))
#define XB_XGEN(j)  (2304 + 64 * (j))
#define XB_TOP      3328
#define XB_TOPGEN   3392
#define XCD_BAR_WORDS 3456
#define XB_SPIN_CAP (1u << 18)
__device__ __forceinline__ unsigned xb_ld(unsigned* p)              { return __hip_atomic_load(p, __ATOMIC_RELAXED, __HIP_MEMORY_SCOPE_AGENT); }
__device__ __forceinline__ unsigned xb_add(unsigned* p, unsigned v) { return __hip_atomic_fetch_add(p, v, __ATOMIC_RELAXED, __HIP_MEMORY_SCOPE_AGENT); }
__device__ __forceinline__ unsigned xb_xcc_id() { return (unsigned)__builtin_amdgcn_s_getreg((3 << 11) | 20) & 0xFu; }
#define XB_SPIN(cond, bar) do { unsigned _sp = 0; while (cond) { __builtin_amdgcn_s_sleep(1); \
    if ((++_sp & 255u) == 0u) { if (xb_ld(&(bar)[XB_TMO])) break; if (_sp > XB_SPIN_CAP) { atomicAdd(&(bar)[XB_TMO], 1u); break; } } } } while (0)
struct XcdBarrier { unsigned* bar; unsigned x; volatile LAS unsigned* st; };
__device__ __forceinline__ XcdBarrier xcd_barrier_post(unsigned* bar, volatile LAS unsigned* st) {
    XcdBarrier b; b.bar = bar; b.x = xb_xcc_id(); b.st = st;
    if (threadIdx.x == 0) (void)xb_add(&bar[XB_XCNT(b.x)], 1u);
    return b;
}
__device__ __forceinline__ void xcd_barrier_complete(unsigned* bar, unsigned x, unsigned& nloc, unsigned& nx) {
    const unsigned G = gridDim.x * gridDim.y * gridDim.z;
    unsigned sum, cnt, mine, sp = 0u;
    for (;;) {
        sum = 0u; cnt = 0u; mine = 0u;
#pragma unroll
        for (unsigned j = 0; j < 16; ++j) { const unsigned c = xb_ld(&bar[XB_XCNT(j)]); sum += c; cnt += (c > 0u) ? 1u : 0u; mine = (j == x) ? c : mine; }
        if (sum == G) break;
        __builtin_amdgcn_s_sleep(1);
        if ((++sp & 255u) == 0u) { if (xb_ld(&bar[XB_TMO])) break; if (sp > XB_SPIN_CAP) { atomicAdd(&bar[XB_TMO], 1u); break; } }
    }
    nloc = mine > 0u ? mine : 1u; nx = cnt > 0u ? cnt : 1u;
}
__device__ __forceinline__ void xcd_barrier(const XcdBarrier& b) {
    asm volatile("s_waitcnt vmcnt(0)" ::: "memory");
    __syncthreads();
    if (threadIdx.x == 0) {
        unsigned* bar = b.bar;
        __builtin_amdgcn_s_waitcnt(0);
        unsigned nloc = b.st[0], nx = b.st[1];
        if (nloc == 0u) { xcd_barrier_complete(bar, b.x, nloc, nx); b.st[0] = nloc; b.st[1] = nx; }
        const unsigned old = xb_add(&bar[XB_XSUB(b.x)], 1u);
        const unsigned gen = old / nloc;
        if (old + 1u == (gen + 1u) * nloc) {
            __builtin_amdgcn_fence(__ATOMIC_RELEASE, "agent");
            asm volatile("s_waitcnt vmcnt(0)" ::: "memory");
            const unsigned og = xb_add(&bar[XB_TOP], 1u);
            const unsigned tg = og / nx;
            if (og + 1u == (tg + 1u) * nx) xb_add(&bar[XB_TOPGEN], 1u);
            else XB_SPIN(xb_ld(&bar[XB_TOPGEN]) == tg, bar);
            __builtin_amdgcn_fence(__ATOMIC_ACQUIRE, "agent");
            xb_add(&bar[XB_XGEN(b.x)], 1u);
            asm volatile("s_waitcnt vmcnt(0)" ::: "memory");
        } else {
            XB_SPIN(xb_ld(&bar[XB_XGEN(b.x)]) == gen, bar);
            __builtin_amdgcn_fence(__ATOMIC_ACQUIRE, "agent");
            asm volatile("s_waitcnt vmcnt(0)" ::: "memory");
        }
    }
    __syncthreads();
}

struct Frame {
    LAS unsigned char* lds;
    int tid, lane, wave, vcu, G;
    unsigned char* ws; const float* x; float* out;
};
#define F_WINT  ((bf16*)(F.ws + WS_WIN))
#define F_WBRT  ((bf16*)(F.ws + WS_WBR))
#define F_WOUTT ((bf16*)(F.ws + WS_WOUT))
#define F_P     ((bf16*)(F.ws + WS_P))
#define F_BR    ((bf16*)(F.ws + WS_BR))
#define F_MG    ((bf16*)(F.ws + WS_MG))
#define F_XB    ((bf16*)(F.ws + WS_XB))
#define F_OG    ((bf16*)(F.ws + WS_OG))
#define F_LSE   ((float*)(F.ws + WS_LSE))
#define F_SSQ   ((float*)(F.ws + WS_SSQ))
#define F_KM    ((float*)(F.ws + WS_KM))
#define F_BIAS  ((float*)(F.ws + WS_BIAS))
#define F_QKG   ((float*)(F.ws + WS_QKG))
#define F_SINK  ((float*)(F.ws + WS_SINK))

__device__ __forceinline__ void p0_transpose_item(const float* W, int ldw, int k0, int n0, bf16* WT, int ldt, int dst_row0, const float* kscale, LAS float* scr, int lane) {
#pragma unroll
    for (int i = 0; i < 32; ++i) { const int kk = 2 * i + (lane >> 5); float v = W[(size_t)(k0 + kk) * ldw + n0 + (lane & 31)]; if (kscale) v *= kscale[k0 + kk]; scr[kk * 33 + (lane & 31)] = v; }
    LDS_WAIT(); asm volatile("" ::: "memory");
    const int c = lane & 7;
#pragma unroll
    for (int j = 0; j < 4; ++j) { const int n = (lane >> 3) + 8 * j; const LAS float* s = scr + (8 * c) * 33 + n;
        v4u o; o.x = cvt_pk_bf16(s[0 * 33], s[1 * 33]); o.y = cvt_pk_bf16(s[2 * 33], s[3 * 33]); o.z = cvt_pk_bf16(s[4 * 33], s[5 * 33]); o.w = cvt_pk_bf16(s[6 * 33], s[7 * 33]);
        *(GAS v4u*)(WT + (size_t)(dst_row0 + n) * ldt + k0 + 8 * c) = o; }
    LDS_WAIT(); asm volatile("" ::: "memory");
}
__device__ __forceinline__ float wave_sum(float v) {
#pragma unroll
    for (int o = 1; o < 64; o <<= 1) v += __shfl_xor(v, o);
    return v;
}
__device__ __forceinline__ int rel_bucket_dev(int dist) {
    if (dist < 16) return dist;
    int b = 16;
    b += dist >= 22; b += dist >= 30; b += dist >= 40; b += dist >= 54; b += dist >= 73; b += dist >= 99; b += dist >= 134; b += dist >= 182;
    b += dist >= 246; b += dist >= 332; b += dist >= 450; b += dist >= 609; b += dist >= 825; b += dist >= 1117; b += dist >= 1513;
    return b;
}
__device__ __forceinline__ void p0_prologue(Frame& F0, const float* ln_g, const float* w_in, const float* qk_g, const float* sinks, const float* w_branch, const float* w_out, const float* rel_bias) {
    Frame F = F0; asm volatile("" : "+v"(F.tid), "+v"(F.lane));
    LAS float* scr = (LAS float*)(F.lds + RING_OFF + F.wave * 16384);
    const int gw = F.vcu * NWAVES + F.wave, NGW = F.G * NWAVES;
    constexpr int I_IN = (DM / 64) * (CIN / 32);
    constexpr int I_BR = (WBR / 64) * (DM / 32);
    constexpr int I_OUT = (DM / 64) * (DM / 32);
    constexpr int N_IN = DEPTH * I_IN, N_BR = DEPTH * 3 * I_BR, N_OUT = DEPTH * I_OUT, NITEMS = N_IN + N_BR + N_OUT;
    for (int it = gw; it < NITEMS; it += NGW) {
        int r = it;
        if (r < N_IN) {
            const int l = r / I_IN, q = r % I_IN, kb = q / (CIN / 32), nb = q % (CIN / 32);
            const int n0 = 32 * nb, pn = n0 >> 8, wc = (n0 >> 6) & 3, bj = (n0 >> 5) & 1, slot0 = 256 * pn + 128 * bj + 32 * wc;
            p0_transpose_item(w_in + (size_t)l * DM * CIN, CIN, 64 * kb, n0, F_WINT + (size_t)l * CIN * DM, DM, slot0, ln_g + l * DM, scr, F.lane);
            continue;
        }
        r -= N_IN;
        if (r < N_BR) {
            const int li = r / I_BR, q = r % I_BR, l = li / 3, i = li % 3, kb = q / (DM / 32), nb = q % (DM / 32);
            p0_transpose_item(w_branch + (size_t)li * WBR * DM, DM, 64 * kb, 32 * nb, F_WBRT + (size_t)l * DM * BRP + i * WBR, BRP, 32 * nb, nullptr, scr, F.lane);
            continue;
        }
        r -= N_BR;
        { const int l = r / I_OUT, q = r % I_OUT, kb = q / (DM / 32), nb = q % (DM / 32);
          p0_transpose_item(w_out + (size_t)l * DM * DM, DM, 64 * kb, 32 * nb, F_WOUTT + (size_t)l * DM * DM, DM, 32 * nb, nullptr, scr, F.lane); }
    }
    for (int m = gw; m < M; m += NGW) {
        const GAS f32x4* xr = (const GAS f32x4*)(F.x + (size_t)m * DM) + F.lane;
        GAS v2u* o8 = (GAS v2u*)(F_XB + (size_t)m * DM) + F.lane;
        float s = 0.f;
#pragma unroll
        for (int j = 0; j < 4; ++j) { const f32x4 v = xr[64 * j]; s += (v[0] * v[0] + v[1] * v[1]) + (v[2] * v[2] + v[3] * v[3]); v2u w; w.x = cvt_pk_bf16(v[0], v[1]); w.y = cvt_pk_bf16(v[2], v[3]); o8[64 * j] = w; }
        s = wave_sum(s);
        if (F.lane < 4) F_SSQ[(size_t)m * 4 + F.lane] = (F.lane == 0) ? s : 0.f;
    }
    for (int i = (F.vcu * NWAVES + F.wave) * 64 + F.lane; i < NH_TOT * SEQ; i += NGW * 64) { const int hd = i / SEQ, dist = i % SEQ; F_BIAS[i] = rel_bias[hd * NBUCK + rel_bucket_dev(dist)] * LOG2E; }
    if (F.vcu == 0) { for (int i = F.tid; i < DEPTH * 6 * HD; i += NWAVES * 64) F_QKG[i] = qk_g[i]; if (F.tid < DEPTH * 8) F_SINK[F.tid] = sinks[F.tid]; }
}

#define PHEAD(hh) (F_P + (size_t)(hh) * M * HD)
struct ATile {
    f32x16 o0, o1; float m, l;
    __device__ __forceinline__ void init() {
#pragma unroll
        for (int r = 0; r < 16; ++r) { o0[r] = 0.f; o1[r] = 0.f; }
        m = -1e30f; l = 0.f;
    }
};
__device__ __forceinline__ s16x4 vtr(const LAS unsigned char* p) { return __builtin_bit_cast(s16x4, __builtin_amdgcn_ds_read_tr16_b64_v4i16((LAS s16x4*)p)); }

struct KVregs { bf16x8 kf[4]; v4u vr[4]; };
__device__ __forceinline__ void at_load_kv(KVregs& R, const bf16* Kt, const bf16* Vt, int lane) {
    const bf16* kp = Kt + (lane & 31) * HD + 8 * (lane >> 5);
#pragma unroll
    for (int ks = 0; ks < 4; ++ks) R.kf[ks] = *(const bf16x8*)(kp + 16 * ks);
#pragma unroll
    for (int i = 0; i < 4; ++i) R.vr[i] = *(const v4u*)(Vt + i * 512 + lane * 8);
}
__device__ __forceinline__ void at_stage_v(const v4u (&vr)[4], LAS unsigned char* vt, int lane) {
#pragma unroll
    for (int i = 0; i < 4; ++i) *(LAS v4u*)(vt + ((lane >> 3) + 8 * i) * VSTR + (lane & 7) * 16) = vr[i];
}
__device__ __forceinline__ void at_softmax_pv(ATile& T, f32x16& s, const LAS unsigned char* vt, int lane) {
    float mx = s[0];
#pragma unroll
    for (int r = 1; r < 16; ++r) mx = fmaxf(mx, s[r]);
    mx = pg8::xhalf_max(mx);
    const float mn = fmaxf(T.m, mx);
    const float alpha = __builtin_amdgcn_exp2f(T.m - mn);
    T.m = mn;
    float ls = 0.f;
#pragma unroll
    for (int r = 0; r < 16; ++r) { s[r] = __builtin_amdgcn_exp2f(s[r] - mn); ls += s[r]; }
    T.l = T.l * alpha + ls;
#pragma unroll
    for (int r = 0; r < 16; ++r) { T.o0[r] *= alpha; T.o1[r] *= alpha; }
    v4u p0, p1;
    p0.x = cvt_pk_bf16(s[0], s[1]); p0.y = cvt_pk_bf16(s[2], s[3]); p0.z = cvt_pk_bf16(s[4], s[5]); p0.w = cvt_pk_bf16(s[6], s[7]);
    p1.x = cvt_pk_bf16(s[8], s[9]); p1.y = cvt_pk_bf16(s[10], s[11]); p1.z = cvt_pk_bf16(s[12], s[13]); p1.w = cvt_pk_bf16(s[14], s[15]);
    const bf16x8 pf0 = __builtin_bit_cast(bf16x8, p0), pf1 = __builtin_bit_cast(bf16x8, p1);
    asm volatile("" ::: "memory");
    const int hi = lane >> 5, dsub = (lane >> 4) & 1, q4 = (lane & 15) >> 2, p4 = lane & 3;
    const LAS unsigned char* vb = vt + (4 * hi + q4) * VSTR + (16 * dsub + 4 * p4) * 2;
#pragma unroll
    for (int dt = 0; dt < 2; ++dt) {
#pragma unroll
        for (int sidx = 0; sidx < 2; ++sidx) {
            const s16x4 lo = vtr(vb + (16 * sidx) * VSTR + dt * 64), hi4 = vtr(vb + (16 * sidx + 8) * VSTR + dt * 64);
            const bf16x8 vf = (bf16x8){lo[0], lo[1], lo[2], lo[3], hi4[0], hi4[1], hi4[2], hi4[3]};
            if (dt == 0) T.o0 = __builtin_amdgcn_mfma_f32_32x32x16_bf16(vf, sidx == 0 ? pf0 : pf1, T.o0, 0, 0, 0);
            else         T.o1 = __builtin_amdgcn_mfma_f32_32x32x16_bf16(vf, sidx == 0 ? pf0 : pf1, T.o1, 0, 0, 0);
        }
    }
    asm volatile("" ::: "memory");
}
__device__ __forceinline__ f32x16 at_qk(const bf16x8 (&kf)[4], const bf16x8 (&qf)[4]) {
    f32x16 s;
#pragma unroll
    for (int r = 0; r < 16; ++r) s[r] = 0.f;
#pragma unroll
    for (int ks = 0; ks < 4; ++ks) s = __builtin_amdgcn_mfma_f32_32x32x16_bf16(kf[ks], qf[ks], s, 0, 0, 0);
    return s;
}
__device__ __forceinline__ void at_store_gated(const ATile& T, float scale, const bf16* gate_row, bf16* out_row, int hi) {
#pragma unroll
    for (int dt = 0; dt < 2; ++dt)
#pragma unroll
        for (int g4 = 0; g4 < 4; ++g4) {
            const int d = 32 * dt + 8 * g4 + 4 * hi;
            const v2u g = *(const v2u*)(gate_row + d);
            const f32x16& o = dt == 0 ? T.o0 : T.o1;
            v2u w; w.x = cvt_pk_bf16(o[4 * g4 + 0] * scale * bf_lo(g.x), o[4 * g4 + 1] * scale * bf_hi(g.x)); w.y = cvt_pk_bf16(o[4 * g4 + 2] * scale * bf_lo(g.y), o[4 * g4 + 3] * scale * bf_hi(g.y));
            *(v2u*)(out_row + d) = w;
        }
}

constexpr int TABN = 2128;
__device__ __forceinline__ void at_step64(ATile& T, f32x16& s0, f32x16& s1, bool sel, const LAS unsigned char* vt, int lane) {
    float mx = fmaxf(s0[0], s1[0]);
#pragma unroll
    for (int r = 1; r < 16; ++r) mx = fmaxf(mx, fmaxf(s0[r], s1[r]));
    mx = pg8::xhalf_max(mx);
    mx = sel ? mx : -INFINITY;
    if (__any(mx > T.m + 8.0f)) {
        const float mn = fmaxf(T.m, mx), alpha = __builtin_amdgcn_exp2f(T.m - mn);
        T.m = mn; T.l *= alpha;
#pragma unroll
        for (int r = 0; r < 16; ++r) { T.o0[r] *= alpha; T.o1[r] *= alpha; }
    }
    const float mref = sel ? T.m : INFINITY;
    float ls = 0.f;
#pragma unroll
    for (int r = 0; r < 16; ++r) { s0[r] = __builtin_amdgcn_exp2f(s0[r] - mref); s1[r] = __builtin_amdgcn_exp2f(s1[r] - mref); ls += s0[r] + s1[r]; }
    T.l += ls;
    v4u pw[4];
    pw[0].x = cvt_pk_bf16(s0[0], s0[1]); pw[0].y = cvt_pk_bf16(s0[2], s0[3]); pw[0].z = cvt_pk_bf16(s0[4], s0[5]); pw[0].w = cvt_pk_bf16(s0[6], s0[7]);
    pw[1].x = cvt_pk_bf16(s0[8], s0[9]); pw[1].y = cvt_pk_bf16(s0[10], s0[11]); pw[1].z = cvt_pk_bf16(s0[12], s0[13]); pw[1].w = cvt_pk_bf16(s0[14], s0[15]);
    pw[2].x = cvt_pk_bf16(s1[0], s1[1]); pw[2].y = cvt_pk_bf16(s1[2], s1[3]); pw[2].z = cvt_pk_bf16(s1[4], s1[5]); pw[2].w = cvt_pk_bf16(s1[6], s1[7]);
    pw[3].x = cvt_pk_bf16(s1[8], s1[9]); pw[3].y = cvt_pk_bf16(s1[10], s1[11]); pw[3].z = cvt_pk_bf16(s1[12], s1[13]); pw[3].w = cvt_pk_bf16(s1[14], s1[15]);
    const int hi = lane >> 5, dsub = (lane >> 4) & 1, q4 = (lane & 15) >> 2, p4 = lane & 3;
    const LAS unsigned char* vb = vt + (4 * hi + q4) * VSTR + (16 * dsub + 4 * p4) * 2;
#pragma unroll
    for (int sidx = 0; sidx < 4; ++sidx) {
        const bf16x8 pf = __builtin_bit_cast(bf16x8, pw[sidx]);
#pragma unroll
        for (int dt = 0; dt < 2; ++dt) {
            const s16x4 lo = vtr(vb + (16 * sidx) * VSTR + dt * 64), hi4 = vtr(vb + (16 * sidx + 8) * VSTR + dt * 64);
            const bf16x8 vf = (bf16x8){lo[0], lo[1], lo[2], lo[3], hi4[0], hi4[1], hi4[2], hi4[3]};
            if (dt == 0) T.o0 = __builtin_amdgcn_mfma_f32_32x32x16_bf16(vf, pf, T.o0, 0, 0, 0);
            else         T.o1 = __builtin_amdgcn_mfma_f32_32x32x16_bf16(vf, pf, T.o1, 0, 0, 0);
        }
    }
}
__device__ __forceinline__ void moba_unit(Frame& F, int b, int h, int qb) {
    LAS float* tab4 = (LAS float*)(F.lds + AT_TAB);
    LAS float* kml = (LAS float*)(F.lds + AT_KM2);
    LAS unsigned char* kring = F.lds + AT_RING2;
    const int lane = F.lane, qi = lane & 31, hi = lane >> 5, tid = F.tid;
    __syncthreads();
    for (int i = tid; i < 4 * TABN; i += NWAVES * 64) { const int k = i / TABN, y = i % TABN + k, dlt = 2047 - y; tab4[i] = dlt >= 0 ? F_BIAS[(OFF_A + h) * SEQ + dlt] : -INFINITY; }
    for (int i = tid; i < qb * 64; i += NWAVES * 64) { const int kb = i >> 6, d = i & 63, pm = b * 8 + kb;
        kml[i] = F_KM[((size_t)(0 * 64 + pm) * 8 + h) * 64 + d] + F_KM[((size_t)(1 * 64 + pm) * 8 + h) * 64 + d]; }
    const size_t rowb = (size_t)b * SEQ;
    const bf16* Kg = PHEAD(8 + h) + rowb * HD; const bf16* Vg = PHEAD(16 + h) + rowb * HD;
    const int ntile = 4 * (qb + 1);
    v4u rk = *(const v4u*)(Kg + tid * 8), rv = *(const v4u*)(Vg + tid * 8);
    const int soff = (tid >> 3) * VSTR + (tid & 7) * 16;
    __syncthreads();
    const int tq0 = qb * 256 + 32 * F.wave;
    const size_t qrow = rowb + tq0 + qi;
    bf16x8 qf[4];
#pragma unroll
    for (int ks = 0; ks < 4; ++ks) qf[ks] = *(const bf16x8*)(PHEAD(0 + h) + qrow * HD + 16 * ks + 8 * hi);
    unsigned selmask = (1u << qb) - 1u;
    if (qb > 3) {
        float gt[7];
#pragma unroll
        for (int kb = 0; kb < 7; ++kb) {
            float a = 0.f;
            if (kb < qb) {
#pragma unroll
                for (int ks = 0; ks < 4; ++ks)
#pragma unroll
                    for (int j = 0; j < 8; ++j) a += __builtin_bit_cast(float, ((unsigned)(unsigned short)qf[ks][j]) << 16) * kml[kb * 64 + 16 * ks + 8 * hi + j];
                a += __shfl_xor(a, 32);
            }
            gt[kb] = a;
        }
        selmask = 0u;
#pragma unroll
        for (int pick = 0; pick < 3; ++pick) {
            float best = -INFINITY; int bi = 0;
#pragma unroll
            for (int kb = 0; kb < 7; ++kb) { const bool ok = (kb < qb) && !((selmask >> kb) & 1u) && (gt[kb] > best); best = ok ? gt[kb] : best; bi = ok ? kb : bi; }
            selmask |= 1u << bi;
        }
    }
    *(LAS v4u*)(kring + soff) = rk; *(LAS v4u*)(kring + 64 * VSTR + soff) = rv;
    __syncthreads();
    const int kcopy = (3 - qi) & 3;
    const LAS float* tabk = tab4 + kcopy * TABN;
    const int ybase = 2047 - (tq0 + qi) + 4 * hi - kcopy;
    ATile T; T.init();
    for (int t = 0; t < ntile; ++t) {
        LAS unsigned char* slot = kring + (t & 1) * (128 * VSTR);
        if (t + 1 < ntile) { rk = *(const v4u*)(Kg + (size_t)(t + 1) * 4096 + tid * 8); rv = *(const v4u*)(Vg + (size_t)(t + 1) * 4096 + tid * 8); }
        const int kb = t >> 2, j = t & 3;
        const bool own = (kb == qb);
        const bool sel = own || ((selmask >> kb) & 1u);
        const bool need = own ? (2 * j <= F.wave) : (__any(sel) != 0);
        if (need) {
            const int tk0 = kb * 256 + 64 * j;
            f32x16 s0, s1;
            { const LAS f32x4* bp = (const LAS f32x4*)(tabk + ybase + tk0);
#pragma unroll
              for (int g = 0; g < 4; ++g) { const f32x4 b0 = bp[2 * g], b1 = bp[8 + 2 * g];
#pragma unroll
                  for (int e = 0; e < 4; ++e) { s0[4 * g + e] = b0[e]; s1[4 * g + e] = b1[e]; } } }
            const LAS unsigned char* kp = slot + qi * VSTR + 16 * hi;
#pragma unroll
            for (int ks = 0; ks < 4; ++ks) {
                const bf16x8 k0 = *(const LAS bf16x8*)(kp + 32 * ks), k1 = *(const LAS bf16x8*)(kp + 32 * VSTR + 32 * ks);
                s0 = __builtin_amdgcn_mfma_f32_32x32x16_bf16(k0, qf[ks], s0, 0, 0, 0);
                s1 = __builtin_amdgcn_mfma_f32_32x32x16_bf16(k1, qf[ks], s1, 0, 0, 0);
            }
            at_step64(T, s0, s1, sel, slot + 64 * VSTR, lane);
        }
        if (t + 1 < ntile) { LAS unsigned char* nslot = kring + ((t + 1) & 1) * (128 * VSTR); *(LAS v4u*)(nslot + soff) = rk; *(LAS v4u*)(nslot + 64 * VSTR + soff) = rv; }
        __syncthreads();
    }
    const float ltot = T.l + __shfl_xor(T.l, 32);
    at_store_gated(T, 1.0f / ltot, PHEAD(24 + h) + qrow * HD, F_BR + qrow * BRP + 0 * WBR + h * 64, hi);
}

__device__ __forceinline__ void swa_unit(Frame& F, int b, int spn, int hq, const float* sinks_l) {
    LAS float* tab = (LAS float*)(F.lds + AT_TAB);
    LAS unsigned char* vt = F.lds + AT_VT + F.wave * AT_VT_WAVE;
    const int lane = F.lane, qi = lane & 31, hi = lane >> 5;
    __syncthreads();
    for (int i = F.tid; i < 192; i += NWAVES * 64) { const int dlt = 160 - i; tab[i] = (dlt >= 0 && dlt < 128) ? F_BIAS[(OFF_C + hq) * SEQ + dlt] : 0.f; }
    __syncthreads();
    const int tq0 = spn * 256 + 32 * F.wave, kvh = hq >> 2;
    const size_t rowb = (size_t)b * SEQ, qrow = rowb + tq0 + qi;
    bf16x8 qf[4];
#pragma unroll
    for (int ks = 0; ks < 4; ++ks) qf[ks] = *(const bf16x8*)(PHEAD(112 + hq) + qrow * HD + 16 * ks + 8 * hi);
    const bf16* Kg = PHEAD(120 + kvh) + rowb * HD; const bf16* Vg = PHEAD(122 + kvh) + rowb * HD;
    const int tq = tq0 + qi; const unsigned lim = (unsigned)(tq < 127 ? tq : 127);
    int kt0 = 4 - (tq0 >> 5); kt0 = kt0 < 0 ? 0 : kt0;
    ATile T; T.init();
    KVregs A; { const int tk0 = tq0 - 128 + 32 * kt0; at_load_kv(A, Kg + (size_t)tk0 * HD, Vg + (size_t)tk0 * HD, lane); }
    for (int kt = kt0; kt < 5; ++kt) {
        const int tk0 = tq0 - 128 + 32 * kt;
        KVregs Bn; { const int ktn = kt + 1 < 5 ? kt + 1 : 4; const int tkn = tq0 - 128 + 32 * ktn; at_load_kv(Bn, Kg + (size_t)tkn * HD, Vg + (size_t)tkn * HD, lane); }
        at_stage_v(A.vr, vt, lane);
        f32x16 s = at_qk(A.kf, qf);
        const int db = tq - tk0 - 4 * hi;
#pragma unroll
        for (int r = 0; r < 16; ++r) { const int c = (r & 3) + 8 * (r >> 2); const int dlt = db - c; s[r] = ((unsigned)dlt <= lim) ? s[r] + tab[(160 - db) + c] : -INFINITY; }
        at_softmax_pv(T, s, vt, lane);
        A = Bn;
    }
    float ltot = T.l + __shfl_xor(T.l, 32);
    const float sk = sinks_l[hq] * LOG2E;
    const float mn = fmaxf(T.m, sk), a = __builtin_amdgcn_exp2f(T.m - mn);
    ltot = ltot * a + __builtin_amdgcn_exp2f(sk - mn);
    at_store_gated(T, a / ltot, PHEAD(124 + hq) + qrow * HD, F_BR + qrow * BRP + 2 * WBR + hq * 64, hi);
}

__device__ __forceinline__ void dil_unit(Frame& F, int b, int h, int sp) {
    LAS float* tab = (LAS float*)(F.lds + AT_TAB);
    LAS unsigned char* vt = F.lds + AT_VT + F.wave * AT_VT_WAVE;
    const int lane = F.lane, qi = lane & 31, hi = lane >> 5;
    const size_t rowb = (size_t)b * SEQ;
    __syncthreads();
    for (int i = F.tid; i < 3 * 192; i += NWAVES * 64) { const int g = i / 192, y = i % 192, dlt = 160 - y, dil = (g == 0) ? 1 : (g == 1 ? 4 : 16);
        tab[i] = (dlt >= 0 && dlt <= 128) ? F_BIAS[(OFF_B + g * 8 + h) * SEQ + (dil * dlt > 2047 ? 2047 : dil * dlt)] : 0.f; }
    __syncthreads();
    for (int g = 0; g < 3; ++g) {
        const int dsh = 2 * g, dil = 1 << dsh;
        for (int t2 = 0; t2 < 2; ++t2) {
            const int tt = 2 * F.wave + t2;
            int res, pq0, nkt, pkb;
            if (g == 0)      { res = 0;       pq0 = 512 * sp + 32 * tt;       nkt = 5;      pkb = pq0 - 128; }
            else if (g == 1) { res = tt >> 2; pq0 = 128 * sp + 32 * (tt & 3); nkt = 5;      pkb = pq0 - 128; }
            else             { res = tt;      pq0 = 32 * sp;                  nkt = sp + 1; pkb = 0; }
            int kt0 = (pkb < 0) ? ((-pkb) >> 5) : 0;
            const int pq = pq0 + qi;
            const size_t rbase = rowb + (size_t)res * (SEQ >> dsh);
            bf16x8 qf[4];
#pragma unroll
            for (int ks = 0; ks < 4; ++ks) qf[ks] = *(const bf16x8*)(PHEAD(32 + g * 8 + h) + (rbase + pq) * HD + 16 * ks + 8 * hi);
            const bf16* Kg = PHEAD(56 + g * 8 + h) + rbase * HD; const bf16* Vg = PHEAD(80 + g * 8 + h) + rbase * HD;
            const unsigned lim = (unsigned)(pq < 128 ? pq : 128);
            ATile T; T.init();
            KVregs A; { const int pk0 = pkb + 32 * kt0; at_load_kv(A, Kg + (size_t)pk0 * HD, Vg + (size_t)pk0 * HD, lane); }
            for (int kt = kt0; kt < nkt; ++kt) {
                const int pk0 = pkb + 32 * kt;
                KVregs Bn; { const int ktn = kt + 1 < nkt ? kt + 1 : nkt - 1; const int pkn = pkb + 32 * ktn; at_load_kv(Bn, Kg + (size_t)pkn * HD, Vg + (size_t)pkn * HD, lane); }
                at_stage_v(A.vr, vt, lane);
                f32x16 s = at_qk(A.kf, qf);
                const int db = pq - pk0 - 4 * hi;
#pragma unroll
                for (int r = 0; r < 16; ++r) { const int c = (r & 3) + 8 * (r >> 2); const int dlt = db - c; s[r] = ((unsigned)dlt <= lim) ? s[r] + tab[g * 192 + (160 - db) + c] : -INFINITY; }
                at_softmax_pv(T, s, vt, lane);
                A = Bn;
            }
            const float ltot = T.l + __shfl_xor(T.l, 32);
            const float inv = 1.0f / ltot;
            const size_t orow = ((size_t)(g * BATCH + b) * 8 + h) * SEQ + (size_t)(dil * pq + res);
            bf16* og = F_OG + orow * HD;
#pragma unroll
            for (int dt = 0; dt < 2; ++dt)
#pragma unroll
                for (int g4 = 0; g4 < 4; ++g4) { const f32x16& o = dt == 0 ? T.o0 : T.o1; v2u w; w.x = cvt_pk_bf16(o[4 * g4 + 0] * inv, o[4 * g4 + 1] * inv); w.y = cvt_pk_bf16(o[4 * g4 + 2] * inv, o[4 * g4 + 3] * inv);
                    *(v2u*)(og + 32 * dt + 8 * g4 + 4 * hi) = w; }
            if (hi == 0) F_LSE[orow] = T.m + __builtin_amdgcn_logf(ltot);
        }
    }
    VM_WAIT(); __syncthreads();
    {
        const int tok = 512 * sp + F.tid;
        const size_t o0r = ((size_t)(0 * BATCH + b) * 8 + h) * SEQ + tok, o1r = ((size_t)(1 * BATCH + b) * 8 + h) * SEQ + tok, o2r = ((size_t)(2 * BATCH + b) * 8 + h) * SEQ + tok;
        const float l0 = F_LSE[o0r], l1 = F_LSE[o1r], l2 = F_LSE[o2r];
        const float mx = fmaxf(l0, fmaxf(l1, l2));
        float w0 = __builtin_amdgcn_exp2f(l0 - mx), w1 = __builtin_amdgcn_exp2f(l1 - mx), w2 = __builtin_amdgcn_exp2f(l2 - mx);
        const float inv = 1.0f / (w0 + w1 + w2); w0 *= inv; w1 *= inv; w2 *= inv;
        const bf16* o0p = F_OG + o0r * HD; const bf16* o1p = F_OG + o1r * HD; const bf16* o2p = F_OG + o2r * HD;
        const size_t row = rowb + tok;
        const bf16* gp = PHEAD(104 + h) + row * HD; bf16* op = F_BR + row * BRP + 1 * WBR + h * 64;
#pragma unroll
        for (int c = 0; c < 8; ++c) {
            const v4u a = *(const v4u*)(o0p + 8 * c), bq = *(const v4u*)(o1p + 8 * c), cq = *(const v4u*)(o2p + 8 * c), gg = *(const v4u*)(gp + 8 * c);
            v4u w;
            w.x = cvt_pk_bf16((w0 * bf_lo(a.x) + w1 * bf_lo(bq.x) + w2 * bf_lo(cq.x)) * bf_lo(gg.x), (w0 * bf_hi(a.x) + w1 * bf_hi(bq.x) + w2 * bf_hi(cq.x)) * bf_hi(gg.x));
            w.y = cvt_pk_bf16((w0 * bf_lo(a.y) + w1 * bf_lo(bq.y) + w2 * bf_lo(cq.y)) * bf_lo(gg.y), (w0 * bf_hi(a.y) + w1 * bf_hi(bq.y) + w2 * bf_hi(cq.y)) * bf_hi(gg.y));
            w.z = cvt_pk_bf16((w0 * bf_lo(a.z) + w1 * bf_lo(bq.z) + w2 * bf_lo(cq.z)) * bf_lo(gg.z), (w0 * bf_hi(a.z) + w1 * bf_hi(bq.z) + w2 * bf_hi(cq.z)) * bf_hi(gg.z));
            w.w = cvt_pk_bf16((w0 * bf_lo(a.w) + w1 * bf_lo(bq.w) + w2 * bf_lo(cq.w)) * bf_lo(gg.w), (w0 * bf_hi(a.w) + w1 * bf_hi(bq.w) + w2 * bf_hi(cq.w)) * bf_hi(gg.w));
            *(v4u*)(op + 8 * c) = w;
        }
    }
}

__device__ __forceinline__ void attn_phase(Frame& F0, int layer) {
    Frame F = F0; asm volatile("" : "+v"(F.tid), "+v"(F.lane));
    for (int rep = 0; rep < ((DBG_TWICE & 4) ? 2 : 1); ++rep)
    for (int u = F.vcu; u < 256; u += F.G) { const int bh = u >> 2, pr = u & 3; moba_unit(F, bh >> 3, bh & 7, pr); moba_unit(F, bh >> 3, bh & 7, 7 - pr); }
    for (int rep = 0; rep < ((DBG_TWICE & 8) ? 2 : 1); ++rep)
    for (int u = F.vcu; u < 256; u += F.G) { const int bh = u >> 2, sp = u & 3; dil_unit(F, bh >> 3, bh & 7, sp); }
    for (int rep = 0; rep < ((DBG_TWICE & 16) ? 2 : 1); ++rep)
    for (int u = F.vcu; u < 512; u += F.G) { const int hq = u & 7, spn = (u >> 3) & 7, b = u >> 6; swa_unit(F, b, spn, hq, F_SINK + layer * 8); }
    __syncthreads();
}

struct Args { const float* in[8]; float* out; unsigned char* ws; int ph_lo, ph_hi; };
__global__ void __launch_bounds__(NWAVES * 64, 2) trunk_fwd(Args args) {
    extern __shared__ __attribute__((aligned(16))) unsigned char lds[];
    Frame F;
    F.lds = (LAS unsigned char*)lds;
    F.tid = threadIdx.x; F.lane = F.tid & 63; F.wave = __builtin_amdgcn_readfirstlane(F.tid >> 6);
    F.G = gridDim.x; { const int bx = blockIdx.x; F.vcu = (F.G % 8 == 0) ? (bx % 8) * (F.G / 8) + bx / 8 : bx; }
    unsigned char* ws = args.ws;
    F.x = args.in[0]; F.ws = ws;
    F.out = args.out;
    for (int u = F.tid; u < (LDS_BYTES - LDSCTL_OFF) / 4; u += NWAVES * 64) ((LAS unsigned*)(F.lds + LDSCTL_OFF))[u] = 0u;
    __syncthreads();
    XcdBarrier bar; bar.bar = (unsigned*)(ws + WS_CTL) + CW_BAR; bar.x = 0; bar.st = nullptr;
    if (!MK_PER_PHASE) bar = xcd_barrier_post((unsigned*)(ws + WS_CTL) + CW_BAR, (volatile LAS unsigned*)(F.lds + MISC_OFF) + 8);
    const int lo = args.ph_lo, hi = args.ph_hi;
#define IN(k) (lo <= (k) && (k) < hi)
#define SEAM(k) do { if (IN(k) && IN((k) + 1)) xcd_barrier(bar); } while (0)
    if (IN(0) && (DBG_PH & 1)) { for (int rep = 0; rep < ((DBG_TWICE & 1) ? 2 : 1); ++rep) p0_prologue(F, args.in[1], args.in[2], args.in[3], args.in[4], args.in[5], args.in[6], args.in[7]); SEAM(0); }
    for (int l = 0; l < DEPTH; ++l) {
        const int p1 = 1 + 4 * l;
        if (IN(p1) && (DBG_PH & 2)) {
            pg8::Gemm g{F_XB, F_WINT + (size_t)l * CIN * DM, M, CIN, DM}; pg8::StaticOrder S; S.init(M, CIN, F.G, (int)blockIdx.x);
            pg8::EpiProj E{F_P, F_SSQ, F_QKG + l * 6 * HD, F_KM};
            if (G1_STAGGER_TICKS > 0) {
                if (F.tid == 0) { const unsigned long long t0 = __builtin_amdgcn_s_memrealtime(), dt = (unsigned long long)(((unsigned)blockIdx.x >> 3) & 3u) * G1_STAGGER_TICKS;
                    while (__builtin_amdgcn_s_memrealtime() - t0 < dt) __builtin_amdgcn_s_sleep(8); }
                __syncthreads();
            }
            if (DBG_TWICE & 128) { pg8::EpiProjT<false> EN{F_P, F_SSQ, F_QKG + l * 6 * HD, F_KM}; pg8::gemm_phase<pg8::EpiProjT<false>, pg8::StaticOrder, true, true>(F.lds + RING_OFF, g, S, EN); }
            if (DBG_TWICE & 64) { pg8::EpiNull EN; pg8::gemm_phase<pg8::EpiNull, pg8::StaticOrder, true, true>(F.lds + RING_OFF, g, S, EN); }
            for (int rep = 0; rep < ((DBG_TWICE & 2) ? 2 : 1); ++rep) pg8::gemm_phase<pg8::EpiProj, pg8::StaticOrder, true, true>(F.lds + RING_OFF, g, S, E);
            SEAM(p1);
        }
        if (IN(p1 + 1) && (DBG_PH & 4)) { attn_phase(F, l); SEAM(p1 + 1); }
        if (IN(p1 + 2) && (DBG_PH & 8)) {
            pg8::Gemm g{F_BR, F_WBRT + (size_t)l * DM * BRP, M, DM, BRP}; pg8::StaticOrder S; S.init(M, DM, F.G, (int)blockIdx.x);
            pg8::EpiMerge E{F_P, F_MG};
            if (DBG_TWICE & 256) { pg8::EpiNull EN; pg8::gemm_phase<pg8::EpiNull, pg8::StaticOrder, true, true>(F.lds + RING_OFF, g, S, EN); }
            for (int rep = 0; rep < ((DBG_TWICE & 32) ? 2 : 1); ++rep) pg8::gemm_phase<pg8::EpiMerge, pg8::StaticOrder, true, true>(F.lds + RING_OFF, g, S, E);
            SEAM(p1 + 2);
        }
        if (IN(p1 + 3) && (DBG_PH & 16)) {
            pg8::Gemm g{F_MG, F_WOUTT + (size_t)l * DM * DM, M, DM, DM}; pg8::StaticOrder S; S.init(M, DM, F.G, (int)blockIdx.x);
            pg8::EpiRes E{l == 0 ? F.x : F.out, F.out, F_XB, F_SSQ};
            pg8::gemm_phase<pg8::EpiRes, pg8::StaticOrder, false, true>(F.lds + RING_OFF, g, S, E);
            if (l + 1 < DEPTH) SEAM(p1 + 3);
        }
    }
#undef IN
#undef SEAM
}

extern "C" void kernel_launch(void* const* d_in, const int* in_sizes, int n_in, void* d_out, int out_size, void* d_ws, size_t ws_size, hipStream_t stream) {
    static int grid = 0;
    if (grid == 0) {
        if (n_in != 8 || in_sizes[0] != M * DM || out_size != M * DM || ws_size < WS_END) { fprintf(stderr, "kernel_launch: unexpected shapes (n_in %d, in0 %d, out %d, ws %zu need %zu); nothing launched\n", n_in, n_in > 0 ? in_sizes[0] : -1, out_size, ws_size, (size_t)WS_END); grid = -1; return; }
        int dev = 0, cus = 0, per_cu = 0;
        if (hipGetDevice(&dev) != hipSuccess || hipDeviceGetAttribute(&cus, hipDeviceAttributeMultiprocessorCount, dev) != hipSuccess) { fprintf(stderr, "kernel_launch: device query failed\n"); grid = -1; return; }
        if (hipFuncSetAttribute((const void*)trunk_fwd, hipFuncAttributeMaxDynamicSharedMemorySize, LDS_BYTES) != hipSuccess) { fprintf(stderr, "kernel_launch: hipFuncSetAttribute failed\n"); grid = -1; return; }
        if (hipOccupancyMaxActiveBlocksPerMultiprocessor(&per_cu, (const void*)trunk_fwd, NWAVES * 64, LDS_BYTES) != hipSuccess || per_cu < 1) fprintf(stderr, "kernel_launch: note: occupancy query reports %d workgroups per CU\n", per_cu);
        (void)hipGetLastError();
        grid = cus;
    }
    if (grid < 0) return;
    if (hipMemsetAsync((char*)d_ws + WS_CTL, 0, CTL_ZERO_BYTES, stream) != hipSuccess) { fprintf(stderr, "kernel_launch: memset failed\n"); return; }
    Args a{};
    for (int i = 0; i < 8; ++i) a.in[i] = (const float*)d_in[i];
    a.out = (float*)d_out; a.ws = (unsigned char*)d_ws;
#if MK_PER_PHASE
    for (int p = 0; p < N_PHASES; ++p) { a.ph_lo = p; a.ph_hi = p + 1; hipLaunchKernelGGL(trunk_fwd, dim3(grid), dim3(NWAVES * 64), LDS_BYTES, stream, a); }
#else
    a.ph_lo = 0; a.ph_hi = N_PHASES;
    hipLaunchKernelGGL(trunk_fwd, dim3(grid), dim3(NWAVES * 64), LDS_BYTES, stream, a);
#endif
    const hipError_t le = hipPeekAtLastError();
    if (le != hipSuccess) fprintf(stderr, "kernel_launch: launch failed: %s\n", hipGetErrorName(le));
}
```

```cpp
#include <hip/hip_runtime.h>
#include <cstdio>
#include <cstdint>

#ifndef DBG_PH
#define DBG_PH 31
#endif
#ifndef DBG_TWICE
#define DBG_TWICE 0
#endif
#ifndef G1_STAGGER_TICKS
#define G1_STAGGER_TICKS 0
#endif
#ifndef DBG_MODE
#define DBG_MODE 0
#endif
#ifndef MK_PER_PHASE
#define MK_PER_PHASE 0
#endif

constexpr int BATCH = 8, SEQ = 2048, DM = 1024, DEPTH = 4, HD = 64, WBR = 512;
constexpr int M = BATCH * SEQ;
constexpr int CIN = 11520;
constexpr int NBUCK = 32, NH_TOT = 40, OFF_A = 0, OFF_B = 8, OFF_C = 32;
constexpr int C_QA = 0, C_KA = 512, C_VA = 1024, C_GA = 1536, C_QB = 2048, C_KB = 3584, C_VB = 5120, C_GB = 6656, C_QC = 7168, C_KC = 7680, C_VC = 7808, C_GC = 7936, C_GL = 8448;
constexpr float LOG2E = 1.4426950408889634f;
constexpr float C2 = 0.125f * LOG2E;
constexpr float EPS = 1e-6f;
constexpr int NHEADS = 132;
constexpr size_t GL_OFF = (size_t)NHEADS * 16384 * 64;
constexpr int BRP = 3 * WBR;

namespace pg8 {
#define PG8_LAS __attribute__((address_space(3)))
typedef unsigned short bf16_t;
typedef short bf16x8 __attribute__((ext_vector_type(8)));
typedef float f32x4 __attribute__((ext_vector_type(4)));
typedef unsigned u32x4 __attribute__((ext_vector_type(4)));
typedef unsigned u32x2 __attribute__((ext_vector_type(2)));
constexpr int BM = 256, BK = 64, HALF = 128, HTB = HALF * BK * 2, STAGE_BYTES = 8 * HTB, NXCD = 8, WGM = 8;

__host__ __device__ __forceinline__ int lds_byte(int r, int c) { const int st = (r >> 4) * 2 + (c >> 5), rr = r & 15, cc = c & 31, ob = rr * 64 + cc * 2; return st * 1024 + (ob ^ (((ob >> 9) & 1) << 5)); }
__host__ __device__ __forceinline__ void stage_rc(int b, int& R, int& C) { const int st = b / 1024, sb = b % 1024, swz = sb ^ (((sb >> 9) & 1) << 5); R = (st >> 1) * 16 + swz / 64; C = (st & 1) * 32 + (swz % 64) / 2; }
__host__ __device__ __forceinline__ int perm32(int rho) { const int n = rho >> 4, i = rho & 15; return 8 * (i >> 2) + 4 * n + (i & 3); }

struct Unit { int pm, pn; };
struct Gemm { const bf16_t* A; const bf16_t* Bt; int M, N, K; };

struct StaticOrder {
    int nM, nN, nwg, G, c;
    __host__ __device__ void init(int M_, int N_, int G_, int c_) { nM = M_ / BM; nN = N_ / BM; nwg = nM * nN; G = G_; c = c_; }
    __host__ __device__ bool next(int i, Unit& u) const {
        const long L = (long)i * G + c; if (L >= nwg) return false;
        int wgid = (int)L; { const int q = nwg / NXCD, r = nwg % NXCD, xcd = wgid % NXCD, off = wgid / NXCD; wgid = (xcd < r ? xcd * (q + 1) : r * (q + 1) + (xcd - r) * q) + off; }
        const int nig = WGM * nN, gid = wgid / nig, fm = gid * WGM, gsz = (nM - fm) < WGM ? (nM - fm) : WGM;
        u.pm = fm + ((wgid % nig) % gsz); u.pn = (wgid % nig) / gsz; return true;
    }
    __device__ __forceinline__ void a_ready(const Unit&) const {}
    __device__ __forceinline__ void done(const Unit&) const {}
};

typedef float f32x2 __attribute__((ext_vector_type(2)));
typedef __bf16 bf16x2_t __attribute__((ext_vector_type(2)));
__device__ __forceinline__ unsigned cvt_pk_bf16(float lo, float hi) { f32x2 v = {lo, hi}; bf16x2_t b = __builtin_convertvector(v, bf16x2_t); return __builtin_bit_cast(unsigned, b); }
__device__ __forceinline__ float bf_lo(unsigned w) { return __builtin_bit_cast(float, w << 16); }
__device__ __forceinline__ float bf_hi(unsigned w) { return __builtin_bit_cast(float, w & 0xffff0000u); }

template <class Epi, class Sched, bool ALIGN_EPI = false, bool SP2 = false>
__device__ __forceinline__ void gemm_phase(PG8_LAS unsigned char* lds, const Gemm g, const Sched& S, const Epi& E) {
    int tid_ = threadIdx.x; asm volatile("" : "+v"(tid_));
    const int tid = tid_, wid = __builtin_amdgcn_readfirstlane(tid >> 6), lane = tid & 63, wr = wid >> 2, wc = wid & 3, fr = lane & 15, fq = lane >> 4;
    const int K = g.K, nt = K / BK;
    unsigned voffA[2], voffB[2];
#pragma unroll
    for (int i = 0; i < 2; ++i) { int R, C; stage_rc(tid * 16 + i * 8192, R, C); const int Rb = Epi::PERM ? ((R & ~31) + perm32(R & 31)) : R;
        voffA[i] = (unsigned)(R * K + C) * 2u; voffB[i] = (unsigned)(Rb * K + C) * 2u; }
    const size_t kstep = (size_t)(BK * 2);
    const size_t hstep = (size_t)HALF * K * 2;
    const size_t tstep = 2 * hstep;
    const unsigned ldsw = (unsigned)wid * 1024u;
    const int aoff = lds_byte(wr * 64 + fr, fq * 8), boff = lds_byte(wc * 32 + fr, fq * 8);
#define PG8_SA(b, h) (((b) * 2 + (h)) * HTB)
#define PG8_SB(b, h) ((4 + (b) * 2 + (h)) * HTB)
#define PG8_STAGE(bufoff, gbase, voff) do { _Pragma("unroll") for (int _i = 0; _i < 2; ++_i) \
        __builtin_amdgcn_global_load_lds((const unsigned*)((const char*)(gbase) + (voff)[_i]), (PG8_LAS unsigned*)(lds + (bufoff) + ldsw + _i * 8192), 16, 0, 0); } while (0)
#define PG8_LDA(dst, b, h) do { _Pragma("unroll") for (int m = 0; m < 4; ++m) _Pragma("unroll") for (int k = 0; k < 2; ++k) dst[m][k] = *(const PG8_LAS bf16x8*)(lds + PG8_SA(b, h) + aoff + m * 2048 + k * 1024); } while (0)
#define PG8_LDB(dst, b, h) do { _Pragma("unroll") for (int n = 0; n < 2; ++n) _Pragma("unroll") for (int k = 0; k < 2; ++k) dst[n][k] = *(const PG8_LAS bf16x8*)(lds + PG8_SB(b, h) + boff + n * 2048 + k * 1024); } while (0)
#define PG8_MMA(ai, bj, At, Bt) do { __builtin_amdgcn_s_setprio(1); _Pragma("unroll") for (int m = 0; m < 4; ++m) _Pragma("unroll") for (int n = 0; n < 2; ++n) _Pragma("unroll") for (int k = 0; k < 2; ++k) \
        acc[ai][bj][m][n] = __builtin_amdgcn_mfma_f32_16x16x32_bf16(Bt[n][k], At[m][k], acc[ai][bj][m][n], 0, 0, 0); __builtin_amdgcn_s_setprio(0); } while (0)
#define PG8_WAIT_V(n) asm volatile("s_waitcnt vmcnt(" #n ")" ::: "memory")
#define PG8_WAIT_L(n) asm volatile("s_waitcnt lgkmcnt(" #n ")" ::: "memory")
#define PG8_BAR __builtin_amdgcn_s_barrier()
#define PG8_SCHED __builtin_amdgcn_sched_barrier(0)
    Unit cur, nxt; int ui = 0;
    if (!S.next(0, cur)) return;
    f32x4 acc[2][2][4][2];
#pragma unroll
    for (int a = 0; a < 2; ++a)
#pragma unroll
        for (int b = 0; b < 2; ++b)
#pragma unroll
            for (int m = 0; m < 4; ++m)
#pragma unroll
                for (int n = 0; n < 2; ++n) acc[a][b][m][n] = (f32x4){0.f, 0.f, 0.f, 0.f};
    bf16x8 At[4][2], B0[2][2], B1[2][2];
    const char* cA = (const char*)g.A + (size_t)cur.pm * tstep; const char* cB = (const char*)g.Bt + (size_t)cur.pn * tstep;
    S.a_ready(cur);
    if constexpr (SP2) {
        PG8_STAGE(PG8_SB(0, 0), cB, voffB); PG8_STAGE(PG8_SB(0, 1), cB + hstep, voffB); PG8_STAGE(PG8_SA(0, 0), cA, voffA); PG8_STAGE(PG8_SA(0, 1), cA + hstep, voffA);
        if (wr == 1) PG8_BAR;
        PG8_WAIT_V(2); PG8_BAR;
        PG8_STAGE(PG8_SB(1, 0), cB + kstep, voffB); PG8_STAGE(PG8_SA(1, 0), cA + kstep, voffA); PG8_STAGE(PG8_SB(1, 1), cB + hstep + kstep, voffB);
        PG8_WAIT_V(6); PG8_BAR;
    } else {
        PG8_STAGE(PG8_SB(0, 0), cB, voffB); PG8_STAGE(PG8_SA(0, 0), cA, voffA); PG8_STAGE(PG8_SB(0, 1), cB + hstep, voffB); PG8_STAGE(PG8_SA(0, 1), cA + hstep, voffA);
        if (wr == 1) PG8_BAR;
        PG8_WAIT_V(4); PG8_BAR;
        PG8_STAGE(PG8_SB(1, 0), cB + kstep, voffB); PG8_STAGE(PG8_SA(1, 0), cA + kstep, voffA); PG8_STAGE(PG8_SB(1, 1), cB + hstep + kstep, voffB);
        PG8_WAIT_V(6); PG8_BAR;
    }
    for (;;) {
        const bool has_next = S.next(ui + 1, nxt);
        const char* nA = has_next ? (const char*)g.A + (size_t)nxt.pm * tstep : cA; const char* nB = has_next ? (const char*)g.Bt + (size_t)nxt.pn * tstep : cB;
        for (int t = 0; t < nt; t += 2) {
            const bool last = (t == nt - 2);
            const char* a1 = cA + (size_t)(t + 1) * kstep;
            const char* a2 = last ? nA : cA + (size_t)(t + 2) * kstep; const char* b2 = last ? nB : cB + (size_t)(t + 2) * kstep;
            const char* a3 = a2 + kstep; const char* b3 = b2 + kstep;
            if (last && has_next) S.a_ready(nxt);
            if constexpr (Epi::PREFETCH) E.prefetch(cur, t, tid, lds + STAGE_BYTES + 1024 + wid * 256);
            if constexpr (Epi::MIDHOOK) { if (t == 8 || t == 16) E.mid(acc, cur, t >> 3, wr, wc, fr, fq); }
            if constexpr (SP2) {
            PG8_LDB(B0, 0, 0); PG8_LDB(B1, 0, 1); PG8_SCHED; PG8_LDA(At, 0, 0); PG8_STAGE(PG8_SA(1, 1), a1 + hstep, voffA);
            PG8_WAIT_V(8); PG8_WAIT_L(0); PG8_BAR; PG8_MMA(0, 0, At, B0); PG8_MMA(0, 1, At, B1); PG8_BAR; PG8_SCHED;
            PG8_LDA(At, 0, 1); PG8_STAGE(PG8_SB(0, 0), b2, voffB); PG8_STAGE(PG8_SB(0, 1), b2 + hstep, voffB); PG8_STAGE(PG8_SA(0, 0), a2, voffA);
            PG8_WAIT_V(8); PG8_WAIT_L(0); PG8_BAR; PG8_MMA(1, 0, At, B0); PG8_MMA(1, 1, At, B1); PG8_BAR; PG8_SCHED;
            PG8_LDB(B0, 1, 0); PG8_LDB(B1, 1, 1); PG8_SCHED; PG8_LDA(At, 1, 0); PG8_STAGE(PG8_SA(0, 1), a2 + hstep, voffA);
            PG8_WAIT_V(8); PG8_WAIT_L(0); PG8_BAR; PG8_MMA(0, 0, At, B0); PG8_MMA(0, 1, At, B1); PG8_BAR; PG8_SCHED;
            PG8_LDA(At, 1, 1); PG8_STAGE(PG8_SB(1, 0), b3, voffB); PG8_STAGE(PG8_SB(1, 1), b3 + hstep, voffB); PG8_STAGE(PG8_SA(1, 0), a3, voffA);
            PG8_WAIT_V(8); PG8_WAIT_L(0); PG8_BAR; PG8_MMA(1, 0, At, B0); PG8_MMA(1, 1, At, B1); PG8_BAR; PG8_SCHED;
            } else {
            PG8_LDB(B0, 0, 0); PG8_SCHED; PG8_LDA(At, 0, 0); PG8_STAGE(PG8_SA(1, 1), a1 + hstep, voffA);
            PG8_WAIT_L(8); PG8_BAR; PG8_WAIT_L(0); PG8_MMA(0, 0, At, B0); PG8_BAR; PG8_SCHED;
            PG8_LDB(B1, 0, 1); PG8_STAGE(PG8_SB(0, 0), b2, voffB);
            PG8_BAR; PG8_WAIT_L(0); PG8_MMA(0, 1, At, B1); PG8_BAR;
            PG8_LDA(At, 0, 1); PG8_STAGE(PG8_SA(0, 0), a2, voffA);
            PG8_BAR; PG8_WAIT_L(0); PG8_MMA(1, 0, At, B0); PG8_BAR; PG8_SCHED;
            PG8_STAGE(PG8_SB(0, 1), b2 + hstep, voffB);
            PG8_WAIT_V(6); PG8_BAR; PG8_MMA(1, 1, At, B1); PG8_BAR;
            PG8_LDB(B0, 1, 0); PG8_SCHED; PG8_LDA(At, 1, 0); PG8_STAGE(PG8_SA(0, 1), a2 + hstep, voffA);
            PG8_WAIT_L(8); PG8_BAR; PG8_WAIT_L(0); PG8_MMA(0, 0, At, B0); PG8_BAR; PG8_SCHED;
            PG8_LDB(B1, 1, 1); PG8_STAGE(PG8_SB(1, 0), b3, voffB);
            PG8_BAR; PG8_WAIT_L(0); PG8_MMA(0, 1, At, B1); PG8_BAR;
            PG8_LDA(At, 1, 1); PG8_STAGE(PG8_SA(1, 0), a3, voffA);
            PG8_BAR; PG8_WAIT_L(0); PG8_MMA(1, 0, At, B0); PG8_BAR; PG8_SCHED;
            PG8_STAGE(PG8_SB(1, 1), b3 + hstep, voffB);
            PG8_WAIT_V(6); PG8_BAR; PG8_MMA(1, 1, At, B1); PG8_BAR;
            }
        }
        if constexpr (ALIGN_EPI) { if (wr == 0) PG8_BAR; }
        if constexpr (!Epi::AFTER_DRAIN) { E(acc, cur, wr, wc, fr, fq); S.done(cur); }
        if (!has_next) break;
#pragma unroll
        for (int a = 0; a < 2; ++a)
#pragma unroll
            for (int b = 0; b < 2; ++b)
#pragma unroll
                for (int m = 0; m < 4; ++m)
#pragma unroll
                    for (int n = 0; n < 2; ++n) acc[a][b][m][n] = (f32x4){0.f, 0.f, 0.f, 0.f};
        cur = nxt; cA = nA; cB = nB; ++ui;
        if constexpr (ALIGN_EPI) { if (wr == 1) PG8_BAR; }
    }
    PG8_WAIT_V(0);
    if constexpr (!ALIGN_EPI) { if (wr == 0) PG8_BAR; }
    PG8_BAR;
    if constexpr (Epi::AFTER_DRAIN) { E.fused(acc, cur, wr, wc, fr, fq, lds, wid, lane); S.done(cur); }
#undef PG8_SA
#undef PG8_SB
#undef PG8_STAGE
#undef PG8_LDA
#undef PG8_LDB
#undef PG8_MMA
#undef PG8_WAIT_V
#undef PG8_WAIT_L
#undef PG8_BAR
#undef PG8_SCHED
}

__device__ __forceinline__ void swap16(float x, float& a, float& b) { a = x; b = x; asm volatile("v_nop\n\tv_nop\n\tv_permlane16_swap_b32 %0, %1" : "+v"(a), "+v"(b)); }
__device__ __forceinline__ void swap32(float x, float& a, float& b) { a = x; b = x; asm volatile("v_nop\n\tv_nop\n\tv_permlane32_swap_b32 %0, %1" : "+v"(a), "+v"(b)); }
__device__ __forceinline__ float xrow16_sum(float x) {
    float a, b; swap16(x, a, b); x = a + b; swap32(x, a, b); return a + b;
}
__device__ __forceinline__ float xhalf_max(float x) { float a, b; swap32(x, a, b); return fmaxf(a, b); }
__device__ __forceinline__ float fast_sigmoid(float v) { return __builtin_amdgcn_rcpf(1.0f + __builtin_amdgcn_exp2f(-v * LOG2E)); }

template <bool STORE = true> struct EpiProjT {
    static constexpr bool PERM = true, MIDHOOK = false, PREFETCH = false, AFTER_DRAIN = false;
    bf16_t* P; const float* ssq; const float* qkg; float* kmean;
    __device__ __forceinline__ void operator()(const f32x4 (&acc)[2][2][4][2], const Unit& u, int wr, int wc, int fr, int fq) const {
        const int hh = 4 * u.pn + wc;
        int type, gi = 0;
        if (hh < 8) { type = 0; gi = 0; } else if (hh < 16) { type = 1; gi = 1; } else if (hh < 24) type = 2; else if (hh < 32) type = 3;
        else if (hh < 56) { type = 0; gi = 2; } else if (hh < 80) { type = 1; gi = 3; } else if (hh < 104) type = 2; else if (hh < 112) type = 3;
        else if (hh < 120) { type = 0; gi = 4; } else if (hh < 122) { type = 1; gi = 5; } else if (hh < 124) type = 2; else if (hh < 132) type = 3; else type = 4;
        const bool is_ka = (hh >= 8 && hh < 16);
        const int dsh = (hh >= 32 && hh < 104) ? 2 * (((hh - 32) % 24) >> 3) : 0;
        f32x4 gn[2][2];
#pragma unroll
        for (int bj = 0; bj < 2; ++bj)
#pragma unroll
            for (int n = 0; n < 2; ++n) gn[bj][n] = (type <= 1) ? *(const f32x4*)(qkg + gi * 64 + 32 * bj + 8 * fq + 4 * n) : (f32x4){1.f, 1.f, 1.f, 1.f};
        f32x4 cs[2][2];
#pragma unroll
        for (int bj = 0; bj < 2; ++bj)
#pragma unroll
            for (int n = 0; n < 2; ++n) cs[bj][n] = (f32x4){0.f, 0.f, 0.f, 0.f};
        float rsv[2][4];
        { f32x4 p4[2][4];
#pragma unroll
          for (int ai = 0; ai < 2; ++ai)
#pragma unroll
            for (int m = 0; m < 4; ++m) p4[ai][m] = *(const f32x4*)(ssq + (size_t)(u.pm * BM + ai * HALF + wr * 64 + m * 16 + fr) * 4);
#pragma unroll
          for (int ai = 0; ai < 2; ++ai)
#pragma unroll
            for (int m = 0; m < 4; ++m) rsv[ai][m] = 1.0f / sqrtf(((p4[ai][m][0] + p4[ai][m][1]) + (p4[ai][m][2] + p4[ai][m][3])) * (1.0f / DM) + EPS); }
#pragma unroll
        for (int ai = 0; ai < 2; ++ai)
#pragma unroll
            for (int m = 0; m < 4; ++m) {
                const int row = u.pm * BM + ai * HALF + wr * 64 + m * 16 + fr;
                const float rs = rsv[ai][m];
                f32x4 v[2][2];
#pragma unroll
                for (int bj = 0; bj < 2; ++bj)
#pragma unroll
                    for (int n = 0; n < 2; ++n) v[bj][n] = acc[ai][bj][m][n] * rs;
                if (type <= 1) {
                    float q = 0.f;
#pragma unroll
                    for (int bj = 0; bj < 2; ++bj)
#pragma unroll
                        for (int n = 0; n < 2; ++n) { const f32x4 x = v[bj][n]; q += (x[0] * x[0] + x[1] * x[1]) + (x[2] * x[2] + x[3] * x[3]); }
                    q = xrow16_sum(q);
                    float rn = 1.0f / sqrtf(q * (1.0f / HD) + EPS); if (type == 0) rn *= C2;
#pragma unroll
                    for (int bj = 0; bj < 2; ++bj)
#pragma unroll
                        for (int n = 0; n < 2; ++n) { v[bj][n] = v[bj][n] * rn * gn[bj][n]; cs[bj][n] += v[bj][n]; }
                } else if (type == 3) {
#pragma unroll
                    for (int bj = 0; bj < 2; ++bj)
#pragma unroll
                        for (int n = 0; n < 2; ++n)
#pragma unroll
                            for (int e = 0; e < 4; ++e) v[bj][n][e] = v[bj][n][e] * fast_sigmoid(v[bj][n][e]);
                } else if (type == 4) {
#pragma unroll
                    for (int bj = 0; bj < 2; ++bj)
#pragma unroll
                        for (int n = 0; n < 2; ++n)
#pragma unroll
                            for (int e = 0; e < 4; ++e) v[bj][n][e] = fast_sigmoid(v[bj][n][e]);
                }
                bf16_t* rowp;
                if (type == 4) rowp = P + GL_OFF + (size_t)row * 3072 + (hh - NHEADS) * 64 + 8 * fq;
                else { int ridx = row;
                    if (dsh) { const int t = row & (SEQ - 1); ridx = (row & ~(SEQ - 1)) + ((t & ((1 << dsh) - 1)) << (11 - dsh)) + (t >> dsh); }
                    rowp = P + ((size_t)hh * M + ridx) * HD + 8 * fq; }
#pragma unroll
                for (int bj = 0; bj < 2; ++bj) { u32x4 w; w.x = cvt_pk_bf16(v[bj][0][0], v[bj][0][1]); w.y = cvt_pk_bf16(v[bj][0][2], v[bj][0][3]); w.z = cvt_pk_bf16(v[bj][1][0], v[bj][1][1]); w.w = cvt_pk_bf16(v[bj][1][2], v[bj][1][3]);
                    if (STORE) *(u32x4*)(rowp + 32 * bj) = w; else asm volatile("" :: "v"(w), "v"(rowp)); }
            }
        if (is_ka) {
#pragma unroll
            for (int bj = 0; bj < 2; ++bj)
#pragma unroll
                for (int n = 0; n < 2; ++n)
#pragma unroll
                    for (int e = 0; e < 4; ++e) { float c = cs[bj][n][e]; c += __shfl_xor(c, 1); c += __shfl_xor(c, 2); c += __shfl_xor(c, 4); c += __shfl_xor(c, 8); cs[bj][n][e] = c; }
            if (fr == 0) {
                float* kp = kmean + ((size_t)(wr * 64 + u.pm) * 8 + (hh - 8)) * 64 + 8 * fq;
#pragma unroll
                for (int bj = 0; bj < 2; ++bj)
#pragma unroll
                    for (int n = 0; n < 2; ++n) *(f32x4*)(kp + 32 * bj + 4 * n) = cs[bj][n];
            }
        }
    }
};

struct EpiNull {
    static constexpr bool PERM = true, MIDHOOK = false, PREFETCH = false, AFTER_DRAIN = false;
    __device__ __forceinline__ void operator()(const f32x4 (&acc)[2][2][4][2], const Unit& u, int wr, int wc, int fr, int fq) const {
#pragma unroll
        for (int a = 0; a < 2; ++a)
#pragma unroll
            for (int b = 0; b < 2; ++b)
#pragma unroll
                for (int m = 0; m < 4; ++m)
#pragma unroll
                    for (int n = 0; n < 2; ++n) asm volatile("" :: "v"(acc[a][b][m][n]));
    }
};
typedef EpiProjT<true> EpiProj;
struct EpiMerge {
    static constexpr bool PERM = true, MIDHOOK = true, PREFETCH = false, AFTER_DRAIN = false;
    const bf16_t* P; bf16_t* MG;
    __device__ __forceinline__ void prefetch(const Unit& u, int t, int tid, PG8_LAS unsigned char* junk) const {
        if (t > 10) return;
        const int L = (t >> 1) * 512 + tid;
        const bf16_t* p = P + GL_OFF + (size_t)(u.pm * BM + ((L >> 2) & 255)) * 3072 + (L >> 10) * DM + u.pn * BM + (L & 3) * 64;
        __builtin_amdgcn_global_load_lds((const unsigned*)p, (PG8_LAS unsigned*)junk, 4, 0, 0);
    }
    __device__ __forceinline__ void mid(f32x4 (&acc)[2][2][4][2], const Unit& u, int seg, int wr, int wc, int fr, int fq) const {
        asm volatile("" : "+v"(fr), "+v"(fq));
#pragma unroll
        for (int ai = 0; ai < 2; ++ai)
#pragma unroll
            for (int m = 0; m < 4; ++m) {
                const int row = u.pm * BM + ai * HALF + wr * 64 + m * 16 + fr;
                const bf16_t* gp = P + GL_OFF + (size_t)row * 3072 + (seg - 1) * DM + u.pn * BM + wc * 32 + 8 * fq;
#pragma unroll
                for (int bj = 0; bj < 2; ++bj) {
                    const u32x4 ga = *(const u32x4*)(gp + bj * HALF), gb = *(const u32x4*)(gp + DM + bj * HALF);
                    f32x4 r0, r1;
                    r0[0] = bf_lo(ga.x) * __builtin_amdgcn_rcpf(fmaxf(bf_lo(gb.x), 1e-30f)); r0[1] = bf_hi(ga.x) * __builtin_amdgcn_rcpf(fmaxf(bf_hi(gb.x), 1e-30f));
                    r0[2] = bf_lo(ga.y) * __builtin_amdgcn_rcpf(fmaxf(bf_lo(gb.y), 1e-30f)); r0[3] = bf_hi(ga.y) * __builtin_amdgcn_rcpf(fmaxf(bf_hi(gb.y), 1e-30f));
                    r1[0] = bf_lo(ga.z) * __builtin_amdgcn_rcpf(fmaxf(bf_lo(gb.z), 1e-30f)); r1[1] = bf_hi(ga.z) * __builtin_amdgcn_rcpf(fmaxf(bf_hi(gb.z), 1e-30f));
                    r1[2] = bf_lo(ga.w) * __builtin_amdgcn_rcpf(fmaxf(bf_lo(gb.w), 1e-30f)); r1[3] = bf_hi(ga.w) * __builtin_amdgcn_rcpf(fmaxf(bf_hi(gb.w), 1e-30f));
                    acc[ai][bj][m][0] *= r0; acc[ai][bj][m][1] *= r1;
                }
                if (m == 3) asm volatile("" ::: "memory");
            }
    }
    __device__ __forceinline__ void operator()(const f32x4 (&acc)[2][2][4][2], const Unit& u, int wr, int wc, int fr, int fq) const {
#pragma unroll
        for (int ai = 0; ai < 2; ++ai)
#pragma unroll
            for (int m = 0; m < 4; ++m) {
                const int row = u.pm * BM + ai * HALF + wr * 64 + m * 16 + fr;
                const int col = u.pn * BM + wc * 32 + 8 * fq;
                const bf16_t* gp = P + GL_OFF + (size_t)row * 3072 + 2 * DM + col;
#pragma unroll
                for (int bj = 0; bj < 2; ++bj) {
                    const u32x4 g = *(const u32x4*)(gp + bj * HALF);
                    const f32x4 a0 = acc[ai][bj][m][0], a1 = acc[ai][bj][m][1];
                    u32x4 w; w.x = cvt_pk_bf16(a0[0] * bf_lo(g.x), a0[1] * bf_hi(g.x)); w.y = cvt_pk_bf16(a0[2] * bf_lo(g.y), a0[3] * bf_hi(g.y));
                    w.z = cvt_pk_bf16(a1[0] * bf_lo(g.z), a1[1] * bf_hi(g.z)); w.w = cvt_pk_bf16(a1[2] * bf_lo(g.w), a1[3] * bf_hi(g.w));
                    *(u32x4*)(MG + (size_t)row * DM + col + bj * HALF) = w;
                }
                if (m == 3) asm volatile("" ::: "memory");
            }
    }
};

struct EpiRes {
    static constexpr bool PERM = false, MIDHOOK = false, PREFETCH = false, AFTER_DRAIN = true;
    const float* xold; float* xout; bf16_t* XB; float* ssq;
    __device__ __forceinline__ void prefetch(const Unit& u, int t, int tid, PG8_LAS unsigned char* junk) const {
        if (tid >= 256) return;
        const int L = (t >> 1) * 256 + tid;
        const float* p = xold + (size_t)(u.pm * BM + (L >> 3)) * DM + u.pn * BM + (L & 7) * 32;
        __builtin_amdgcn_global_load_lds((const unsigned*)p, (PG8_LAS unsigned*)junk, 4, 0, 0);
    }
    __device__ __forceinline__ void fused(const f32x4 (&acc)[2][2][4][2], const Unit& u, int wr, int wc, int fr, int fq, PG8_LAS unsigned char* lds, int wid, int lane) const {
        PG8_LAS float* part = (PG8_LAS float*)lds;
#pragma unroll
        for (int ai = 0; ai < 2; ++ai)
#pragma unroll
            for (int m = 0; m < 4; ++m) {
                const int r = ai * HALF + wr * 64 + m * 16 + fr;
                const size_t off = (size_t)(u.pm * BM + r) * DM + u.pn * BM + wc * 32 + 4 * fq;
                float ss = 0.f;
#pragma unroll
                for (int bj = 0; bj < 2; ++bj)
#pragma unroll
                    for (int n = 0; n < 2; ++n) {
                        const size_t o = off + bj * HALF + n * 16;
                        const f32x4 x = *(const f32x4*)(xold + o) + acc[ai][bj][m][n];
                        *(f32x4*)(xout + o) = x;
                        u32x2 w; w.x = cvt_pk_bf16(x[0], x[1]); w.y = cvt_pk_bf16(x[2], x[3]); *(u32x2*)(XB + o) = w;
                        ss += (x[0] * x[0] + x[1] * x[1]) + (x[2] * x[2] + x[3] * x[3]);
                    }
                ss = xrow16_sum(ss);
                if (fq == 0) part[r * 4 + wc] = ss;
                if (m & 1) asm volatile("" ::: "memory");
            }
        asm volatile("s_waitcnt lgkmcnt(0)" ::: "memory"); __builtin_amdgcn_s_barrier(); asm volatile("" ::: "memory");
        const int tid = wid * 64 + lane;
        if (tid < 256) { const f32x4 p = *(const PG8_LAS f32x4*)(part + tid * 4); ssq[(size_t)(u.pm * BM + tid) * 4 + u.pn] = (p[0] + p[1]) + (p[2] + p[3]); }
    }
};
}

constexpr int NWAVES = 8;
constexpr int N_PHASES = 1 + 4 * DEPTH;
constexpr size_t MiB = 1u << 20;
constexpr size_t WS_CTL = 0, CTL_ZERO_BYTES = 1 * MiB;
constexpr size_t WS_WIN = 1 * MiB;
constexpr size_t WS_WBR = WS_WIN + (size_t)DEPTH * CIN * DM * 2;
constexpr size_t WS_WOUT = WS_WBR + (size_t)DEPTH * DM * BRP * 2;
constexpr size_t WS_P = WS_WOUT + (size_t)DEPTH * DM * DM * 2;
constexpr size_t WS_BR = WS_P + (size_t)M * CIN * 2;
constexpr size_t WS_MG = WS_BR + (size_t)M * BRP * 2;
constexpr size_t WS_XB = WS_MG + (size_t)M * DM * 2;
constexpr size_t WS_OG = WS_XB + (size_t)M * DM * 2;
constexpr size_t WS_LSE = WS_OG + (size_t)3 * M * WBR * 2;
constexpr size_t WS_SSQ = WS_LSE + (size_t)3 * M * 8 * 4;
constexpr size_t WS_KM = WS_SSQ + (size_t)M * 16 * 4;
constexpr size_t WS_BIAS = WS_KM + (size_t)2 * 64 * 8 * 64 * 4;
constexpr size_t WS_QKG = WS_BIAS + (size_t)NH_TOT * SEQ * 4;
constexpr size_t WS_SINK = WS_QKG + (size_t)DEPTH * 6 * HD * 4;
constexpr size_t WS_END = WS_SINK + 4096;
constexpr int CW_BAR = 4096;

constexpr int RING_OFF = 0, RING_BYTES = 131072;
constexpr int LDSCTL_OFF = RING_BYTES, MISC_OFF = LDSCTL_OFF + 320;
constexpr int LDS_BYTES = 147456;
constexpr int VSTR = 144;
constexpr int AT_VT = 0, AT_VT_WAVE = 32 * VSTR;
constexpr int AT_TAB = 40960;
constexpr int AT_KM = AT_TAB + 2080 * 4;
constexpr int AT_RING = AT_KM + 8 * 64 * 4;
constexpr int AT_KM2 = AT_TAB + 4 * 2128 * 4;
constexpr int AT_RING2 = AT_KM2 + 8 * 64 * 4;
static_assert(AT_VT + NWAVES * AT_VT_WAVE <= AT_TAB && AT_RING2 + 2 * 128 * VSTR <= RING_BYTES && AT_RING2 % 16 == 0 && AT_TAB % 16 == 0, "attention LDS map");

#define GAS __attribute__((address_space(1)))
#define LAS __attribute__((address_space(3)))
typedef unsigned short bf16;
typedef unsigned v4u __attribute__((ext_vector_type(4)));
typedef unsigned v2u __attribute__((ext_vector_type(2)));
typedef float f32x4 __attribute__((ext_vector_type(4)));
typedef float f32x16 __attribute__((ext_vector_type(16)));
typedef short bf16x8 __attribute__((ext_vector_type(8)));
typedef short s16x4 __attribute__((ext_vector_type(4)));
typedef GAS unsigned gu32;
#define RLX_AGENT __ATOMIC_RELAXED, __HIP_MEMORY_SCOPE_AGENT
#define LDS_WAIT() asm volatile("s_waitcnt lgkmcnt(0)" ::: "memory")
#define VM_WAIT() asm volatile("s_waitcnt vmcnt(0)" ::: "memory")
using pg8::cvt_pk_bf16; using pg8::bf_lo; using pg8::bf_hi;

#define XB_TMO      128
#define XB_XCNT(j)  (256  + 64 * (j))
#define XB_XSUB(j)  (1280 + 64 * (j))
#define XB_XGEN(j)  (2304 + 64 * (j))
#define XB_TOP      3328
#define XB_TOPGEN   3392
#define XCD_BAR_WORDS 3456
#define XB_SPIN_CAP (1u << 18)
__device__ __forceinline__ unsigned xb_ld(unsigned* p)              { return __hip_atomic_load(p, __ATOMIC_RELAXED, __HIP_MEMORY_SCOPE_AGENT); }
__device__ __forceinline__ unsigned xb_add(unsigned* p, unsigned v) { return __hip_atomic_fetch_add(p, v, __ATOMIC_RELAXED, __HIP_MEMORY_SCOPE_AGENT); }
__device__ __forceinline__ unsigned xb_xcc_id() { return (unsigned)__builtin_amdgcn_s_getreg((3 << 11) | 20) & 0xFu; }
#define XB_SPIN(cond, bar) do { unsigned _sp = 0; while (cond) { __builtin_amdgcn_s_sleep(1); \
    if ((++_sp & 255u) == 0u) { if (xb_ld(&(bar)[XB_TMO])) break; if (_sp > XB_SPIN_CAP) { atomicAdd(&(bar)[XB_TMO], 1u); break; } } } } while (0)
struct XcdBarrier { unsigned* bar; unsigned x; volatile LAS unsigned* st; };
__device__ __forceinline__ XcdBarrier xcd_barrier_post(unsigned* bar, volatile LAS unsigned* st) {
    XcdBarrier b; b.bar = bar; b.x = xb_xcc_id(); b.st = st;
    if (threadIdx.x == 0) (void)xb_add(&bar[XB_XCNT(b.x)], 1u);
    return b;
}
__device__ __forceinline__ void xcd_barrier_complete(unsigned* bar, unsigned x, unsigned& nloc, unsigned& nx) {
    const unsigned G = gridDim.x * gridDim.y * gridDim.z;
    unsigned sum, cnt, mine, sp = 0u;
    for (;;) {
        sum = 0u; cnt = 0u; mine = 0u;
#pragma unroll
        for (unsigned j = 0; j < 16; ++j) { const unsigned c = xb_ld(&bar[XB_XCNT(j)]); sum += c; cnt += (c > 0u) ? 1u : 0u; mine = (j == x) ? c : mine; }
        if (sum == G) break;
        __builtin_amdgcn_s_sleep(1);
        if ((++sp & 255u) == 0u) { if (xb_ld(&bar[XB_TMO])) break; if (sp > XB_SPIN_CAP) { atomicAdd(&bar[XB_TMO], 1u); break; } }
    }
    nloc = mine > 0u ? mine : 1u; nx = cnt > 0u ? cnt : 1u;
}
__device__ __forceinline__ void xcd_barrier(const XcdBarrier& b) {
    asm volatile("s_waitcnt vmcnt(0)" ::: "memory");
    __syncthreads();
    if (threadIdx.x == 0) {
        unsigned* bar = b.bar;
        __builtin_amdgcn_s_waitcnt(0);
        unsigned nloc = b.st[0], nx = b.st[1];
        if (nloc == 0u) { xcd_barrier_complete(bar, b.x, nloc, nx); b.st[0] = nloc; b.st[1] = nx; }
        const unsigned old = xb_add(&bar[XB_XSUB(b.x)], 1u);
        const unsigned gen = old / nloc;
        if (old + 1u == (gen + 1u) * nloc) {
            __builtin_amdgcn_fence(__ATOMIC_RELEASE, "agent");
            asm volatile("s_waitcnt vmcnt(0)" ::: "memory");
            const unsigned og = xb_add(&bar[XB_TOP], 1u);
            const unsigned tg = og / nx;
            if (og + 1u == (tg + 1u) * nx) xb_add(&bar[XB_TOPGEN], 1u);
            else XB_SPIN(xb_ld(&bar[XB_TOPGEN]) == tg, bar);
            __builtin_amdgcn_fence(__ATOMIC_ACQUIRE, "agent");
            xb_add(&bar[XB_XGEN(b.x)], 1u);
            asm volatile("s_waitcnt vmcnt(0)" ::: "memory");
        } else {
            XB_SPIN(xb_ld(&bar[XB_XGEN(b.x)]) == gen, bar);
            __builtin_amdgcn_fence(__ATOMIC_ACQUIRE, "agent");
            asm volatile("s_waitcnt vmcnt(0)" ::: "memory");
        }
    }
    __syncthreads();
}

struct Frame {
    LAS unsigned char* lds;
    int tid, lane, wave, vcu, G;
    unsigned char* ws; const float* x; float* out;
};
#define F_WINT  ((bf16*)(F.ws + WS_WIN))
#define F_WBRT  ((bf16*)(F.ws + WS_WBR))
#define F_WOUTT ((bf16*)(F.ws + WS_WOUT))
#define F_P     ((bf16*)(F.ws + WS_P))
#define F_BR    ((bf16*)(F.ws + WS_BR))
#define F_MG    ((bf16*)(F.ws + WS_MG))
#define F_XB    ((bf16*)(F.ws + WS_XB))
#define F_OG    ((bf16*)(F.ws + WS_OG))
#define F_LSE   ((float*)(F.ws + WS_LSE))
#define F_SSQ   ((float*)(F.ws + WS_SSQ))
#define F_KM    ((float*)(F.ws + WS_KM))
#define F_BIAS  ((float*)(F.ws + WS_BIAS))
#define F_QKG   ((float*)(F.ws + WS_QKG))
#define F_SINK  ((float*)(F.ws + WS_SINK))

__device__ __forceinline__ void p0_transpose_item(const float* W, int ldw, int k0, int n0, bf16* WT, int ldt, int dst_row0, const float* kscale, LAS float* scr, int lane) {
#pragma unroll
    for (int i = 0; i < 32; ++i) { const int kk = 2 * i + (lane >> 5); float v = W[(size_t)(k0 + kk) * ldw + n0 + (lane & 31)]; if (kscale) v *= kscale[k0 + kk]; scr[kk * 33 + (lane & 31)] = v; }
    LDS_WAIT(); asm volatile("" ::: "memory");
    const int c = lane & 7;
#pragma unroll
    for (int j = 0; j < 4; ++j) { const int n = (lane >> 3) + 8 * j; const LAS float* s = scr + (8 * c) * 33 + n;
        v4u o; o.x = cvt_pk_bf16(s[0 * 33], s[1 * 33]); o.y = cvt_pk_bf16(s[2 * 33], s[3 * 33]); o.z = cvt_pk_bf16(s[4 * 33], s[5 * 33]); o.w = cvt_pk_bf16(s[6 * 33], s[7 * 33]);
        *(GAS v4u*)(WT + (size_t)(dst_row0 + n) * ldt + k0 + 8 * c) = o; }
    LDS_WAIT(); asm volatile("" ::: "memory");
}
__device__ __forceinline__ float wave_sum(float v) {
#pragma unroll
    for (int o = 1; o < 64; o <<= 1) v += __shfl_xor(v, o);
    return v;
}
__device__ __forceinline__ int rel_bucket_dev(int dist) {
    if (dist < 16) return dist;
    int b = 16;
    b += dist >= 22; b += dist >= 30; b += dist >= 40; b += dist >= 54; b += dist >= 73; b += dist >= 99; b += dist >= 134; b += dist >= 182;
    b += dist >= 246; b += dist >= 332; b += dist >= 450; b += dist >= 609; b += dist >= 825; b += dist >= 1117; b += dist >= 1513;
    return b;
}
__device__ __forceinline__ void p0_prologue(Frame& F0, const float* ln_g, const float* w_in, const float* qk_g, const float* sinks, const float* w_branch, const float* w_out, const float* rel_bias) {
    Frame F = F0; asm volatile("" : "+v"(F.tid), "+v"(F.lane));
    LAS float* scr = (LAS float*)(F.lds + RING_OFF + F.wave * 16384);
    const int gw = F.vcu * NWAVES + F.wave, NGW = F.G * NWAVES;
    constexpr int I_IN = (DM / 64) * (CIN / 32);
    constexpr int I_BR = (WBR / 64) * (DM / 32);
    constexpr int I_OUT = (DM / 64) * (DM / 32);
    constexpr int N_IN = DEPTH * I_IN, N_BR = DEPTH * 3 * I_BR, N_OUT = DEPTH * I_OUT, NITEMS = N_IN + N_BR + N_OUT;
    for (int it = gw; it < NITEMS; it += NGW) {
        int r = it;
        if (r < N_IN) {
            const int l = r / I_IN, q = r % I_IN, kb = q / (CIN / 32), nb = q % (CIN / 32);
            const int n0 = 32 * nb, pn = n0 >> 8, wc = (n0 >> 6) & 3, bj = (n0 >> 5) & 1, slot0 = 256 * pn + 128 * bj + 32 * wc;
            p0_transpose_item(w_in + (size_t)l * DM * CIN, CIN, 64 * kb, n0, F_WINT + (size_t)l * CIN * DM, DM, slot0, ln_g + l * DM, scr, F.lane);
            continue;
        }
        r -= N_IN;
        if (r < N_BR) {
            const int li = r / I_BR, q = r % I_BR, l = li / 3, i = li % 3, kb = q / (DM / 32), nb = q % (DM / 32);
            p0_transpose_item(w_branch + (size_t)li * WBR * DM, DM, 64 * kb, 32 * nb, F_WBRT + (size_t)l * DM * BRP + i * WBR, BRP, 32 * nb, nullptr, scr, F.lane);
            continue;
        }
        r -= N_BR;
        { const int l = r / I_OUT, q = r % I_OUT, kb = q / (DM / 32), nb = q % (DM / 32);
          p0_transpose_item(w_out + (size_t)l * DM * DM, DM, 64 * kb, 32 * nb, F_WOUTT + (size_t)l * DM * DM, DM, 32 * nb, nullptr, scr, F.lane); }
    }
    for (int m = gw; m < M; m += NGW) {
        const GAS f32x4* xr = (const GAS f32x4*)(F.x + (size_t)m * DM) + F.lane;
        GAS v2u* o8 = (GAS v2u*)(F_XB + (size_t)m * DM) + F.lane;
        float s = 0.f;
#pragma unroll
        for (int j = 0; j < 4; ++j) { const f32x4 v = xr[64 * j]; s += (v[0] * v[0] + v[1] * v[1]) + (v[2] * v[2] + v[3] * v[3]); v2u w; w.x = cvt_pk_bf16(v[0], v[1]); w.y = cvt_pk_bf16(v[2], v[3]); o8[64 * j] = w; }
        s = wave_sum(s);
        if (F.lane < 4) F_SSQ[(size_t)m * 4 + F.lane] = (F.lane == 0) ? s : 0.f;
    }
    for (int i = (F.vcu * NWAVES + F.wave) * 64 + F.lane; i < NH_TOT * SEQ; i += NGW * 64) { const int hd = i / SEQ, dist = i % SEQ; F_BIAS[i] = rel_bias[hd * NBUCK + rel_bucket_dev(dist)] * LOG2E; }
    if (F.vcu == 0) { for (int i = F.tid; i < DEPTH * 6 * HD; i += NWAVES * 64) F_QKG[i] = qk_g[i]; if (F.tid < DEPTH * 8) F_SINK[F.tid] = sinks[F.tid]; }
}

#define PHEAD(hh) (F_P + (size_t)(hh) * M * HD)
struct ATile {
    f32x16 o0, o1, ls;
    __device__ __forceinline__ void init() {
#pragma unroll
        for (int r = 0; r < 16; ++r) { o0[r] = 0.f; o1[r] = 0.f; ls[r] = 0.f; }
    }
};
__device__ __forceinline__ s16x4 vtr(const LAS unsigned char* p) { return __builtin_bit_cast(s16x4, __builtin_amdgcn_ds_read_tr16_b64_v4i16((LAS s16x4*)p)); }

struct KVregs { bf16x8 kf[4]; v4u vr[4]; };
__device__ __forceinline__ void at_load_kv(KVregs& R, const bf16* Kt, const bf16* Vt, int lane) {
    const bf16* kp = Kt + (lane & 31) * HD + 8 * (lane >> 5);
#pragma unroll
    for (int ks = 0; ks < 4; ++ks) R.kf[ks] = *(const bf16x8*)(kp + 16 * ks);
#pragma unroll
    for (int i = 0; i < 4; ++i) R.vr[i] = *(const v4u*)(Vt + i * 512 + lane * 8);
}
__device__ __forceinline__ void at_stage_v(const v4u (&vr)[4], LAS unsigned char* vt, int lane) {
#pragma unroll
    for (int i = 0; i < 4; ++i) *(LAS v4u*)(vt + ((lane >> 3) + 8 * i) * VSTR + (lane & 7) * 16) = vr[i];
}
template <int NS> __device__ __forceinline__ void at_read_v(bf16x8 (&vf)[NS][2], const LAS unsigned char* vt, int lane) {
    const int hi = lane >> 5, dsub = (lane >> 4) & 1, q4 = (lane & 15) >> 2, p4 = lane & 3;
    const LAS unsigned char* vb = vt + (4 * hi + q4) * VSTR + (16 * dsub + 4 * p4) * 2;
#pragma unroll
    for (int sidx = 0; sidx < NS; ++sidx)
#pragma unroll
        for (int dt = 0; dt < 2; ++dt) {
            const s16x4 lo = vtr(vb + (16 * sidx) * VSTR + dt * 64), hi4 = vtr(vb + (16 * sidx + 8) * VSTR + dt * 64);
            vf[sidx][dt] = (bf16x8){lo[0], lo[1], lo[2], lo[3], hi4[0], hi4[1], hi4[2], hi4[3]};
        }
}
__device__ __forceinline__ f32x16 at_bias(const LAS float* tp) {
    f32x16 s; const LAS f32x4* bp = (const LAS f32x4*)tp;
#pragma unroll
    for (int g = 0; g < 4; ++g) { const f32x4 b = bp[2 * g];
#pragma unroll
        for (int e = 0; e < 4; ++e) s[4 * g + e] = b[e]; }
    return s;
}
template <int NT> __device__ __forceinline__ void at_step(ATile& T, f32x16 (&s)[NT], const LAS unsigned char* vt, int lane) {
    bf16x8 vf[2 * NT][2];
    at_read_v<2 * NT>(vf, vt, lane);
    __builtin_amdgcn_sched_barrier(0);
    v4u pw[2 * NT];
#pragma unroll
    for (int t = 0; t < NT; ++t) {
#pragma unroll
        for (int r = 0; r < 16; ++r) s[t][r] = __builtin_amdgcn_exp2f(s[t][r]);
        pw[2 * t].x = cvt_pk_bf16(s[t][0], s[t][1]); pw[2 * t].y = cvt_pk_bf16(s[t][2], s[t][3]); pw[2 * t].z = cvt_pk_bf16(s[t][4], s[t][5]); pw[2 * t].w = cvt_pk_bf16(s[t][6], s[t][7]);
        pw[2 * t + 1].x = cvt_pk_bf16(s[t][8], s[t][9]); pw[2 * t + 1].y = cvt_pk_bf16(s[t][10], s[t][11]); pw[2 * t + 1].z = cvt_pk_bf16(s[t][12], s[t][13]); pw[2 * t + 1].w = cvt_pk_bf16(s[t][14], s[t][15]);
    }
    __builtin_amdgcn_sched_barrier(0);
    const bf16x8 ones = (bf16x8){0x3F80, 0x3F80, 0x3F80, 0x3F80, 0x3F80, 0x3F80, 0x3F80, 0x3F80};
#pragma unroll
    for (int sidx = 0; sidx < 2 * NT; ++sidx) {
        const bf16x8 pf = __builtin_bit_cast(bf16x8, pw[sidx]);
        T.o0 = __builtin_amdgcn_mfma_f32_32x32x16_bf16(vf[sidx][0], pf, T.o0, 0, 0, 0);
        T.o1 = __builtin_amdgcn_mfma_f32_32x32x16_bf16(vf[sidx][1], pf, T.o1, 0, 0, 0);
        T.ls = __builtin_amdgcn_mfma_f32_32x32x16_bf16(ones, pf, T.ls, 0, 0, 0);
    }
}
__device__ __forceinline__ void at_stage_o(const ATile& T, float scale, LAS unsigned char* vt, int lane) {
    const int qi = lane & 31, hi = lane >> 5;
#pragma unroll
    for (int dt = 0; dt < 2; ++dt)
#pragma unroll
        for (int g4 = 0; g4 < 4; ++g4) {
            const f32x16& o = dt == 0 ? T.o0 : T.o1;
            v2u w; w.x = cvt_pk_bf16(o[4 * g4 + 0] * scale, o[4 * g4 + 1] * scale); w.y = cvt_pk_bf16(o[4 * g4 + 2] * scale, o[4 * g4 + 3] * scale);
            *(LAS v2u*)(vt + qi * VSTR + (32 * dt + 8 * g4 + 4 * hi) * 2) = w;
        }
    asm volatile("" ::: "memory");
}
__device__ __forceinline__ v4u mul_bf16x8(v4u a, v4u g) {
    v4u w;
    w.x = cvt_pk_bf16(bf_lo(a.x) * bf_lo(g.x), bf_hi(a.x) * bf_hi(g.x)); w.y = cvt_pk_bf16(bf_lo(a.y) * bf_lo(g.y), bf_hi(a.y) * bf_hi(g.y));
    w.z = cvt_pk_bf16(bf_lo(a.z) * bf_lo(g.z), bf_hi(a.z) * bf_hi(g.z)); w.w = cvt_pk_bf16(bf_lo(a.w) * bf_lo(g.w), bf_hi(a.w) * bf_hi(g.w));
    return w;
}
__device__ __forceinline__ void at_store_gated(const ATile& T, float scale, const bf16* gate0, bf16* out0, LAS unsigned char* vt, int lane) {
    at_stage_o(T, scale, vt, lane);
#pragma unroll
    for (int i = 0; i < 4; ++i) {
        const int r = 8 * i + (lane >> 3), ch = lane & 7;
        const v4u o = *(const LAS v4u*)(vt + r * VSTR + ch * 16);
        const v4u g = *(const v4u*)(gate0 + (size_t)r * HD + ch * 8);
        *(v4u*)(out0 + (size_t)r * BRP + ch * 8) = mul_bf16x8(o, g);
    }
    asm volatile("" ::: "memory");
}

constexpr int TABN = 2128;
template <int MODE> __device__ __forceinline__ void moba_unit(Frame& F, int b, int h, int qb) {
    LAS float* tab4 = (LAS float*)(F.lds + AT_TAB);
    LAS float* kml = (LAS float*)(F.lds + AT_KM2);
    LAS unsigned char* kring = F.lds + AT_RING2;
    const int lane = F.lane, qi = lane & 31, hi = lane >> 5, tid = F.tid;
    __syncthreads();
    for (int y = tid; y < TABN + 3; y += NWAVES * 64) {
        const int dlt = 2047 - y; const float v = dlt >= 0 ? F_BIAS[(OFF_A + h) * SEQ + dlt] : -INFINITY;
#pragma unroll
        for (int k = 0; k < 4; ++k) { const int i = y - k; if (i >= 0 && i < TABN) tab4[k * TABN + i] = v; }
    }
    for (int i = tid; i < qb * 64; i += NWAVES * 64) { const int kb = i >> 6, d = i & 63, pm = b * 8 + kb;
        kml[i] = F_KM[((size_t)(0 * 64 + pm) * 8 + h) * 64 + d] + F_KM[((size_t)(1 * 64 + pm) * 8 + h) * 64 + d]; }
    const size_t rowb = (size_t)b * SEQ;
    const bf16* Kg = PHEAD(8 + h) + rowb * HD; const bf16* Vg = PHEAD(16 + h) + rowb * HD;
    const int ntile = 4 * (qb + 1);
    v4u rk = *(const v4u*)(Kg + tid * 8), rv = *(const v4u*)(Vg + tid * 8);
    const int soff = (tid >> 3) * VSTR + (tid & 7) * 16;
    __syncthreads();
    const int tq0 = qb * 256 + 32 * F.wave;
    const size_t qrow = rowb + tq0 + qi;
    bf16x8 qf[4];
#pragma unroll
    for (int ks = 0; ks < 4; ++ks) qf[ks] = *(const bf16x8*)(PHEAD(0 + h) + qrow * HD + 16 * ks + 8 * hi);
    unsigned selmask = (1u << qb) - 1u;
    if (qb > 3) {
        float gt[7];
#pragma unroll
        for (int kb = 0; kb < 7; ++kb) {
            float a = 0.f;
            if (kb < qb) {
#pragma unroll
                for (int ks = 0; ks < 4; ++ks)
#pragma unroll
                    for (int j = 0; j < 8; ++j) a += __builtin_bit_cast(float, ((unsigned)(unsigned short)qf[ks][j]) << 16) * kml[kb * 64 + 16 * ks + 8 * hi + j];
                a += __shfl_xor(a, 32);
            }
            gt[kb] = a;
        }
        selmask = 0u;
#pragma unroll
        for (int pick = 0; pick < 3; ++pick) {
            float best = -INFINITY; int bi = 0;
#pragma unroll
            for (int kb = 0; kb < 7; ++kb) { const bool ok = (kb < qb) && !((selmask >> kb) & 1u) && (gt[kb] > best); best = ok ? gt[kb] : best; bi = ok ? kb : bi; }
            selmask |= 1u << bi;
        }
    }
    *(LAS v4u*)(kring + soff) = rk; *(LAS v4u*)(kring + 64 * VSTR + soff) = rv;
    __syncthreads();
    const int kcopy = (3 - qi) & 3;
    const LAS float* tabk = tab4 + kcopy * TABN;
    const int ybase = 2047 - (tq0 + qi) + 4 * hi - kcopy;
    ATile T; T.init();
    for (int t = 0; t < ntile; ++t) {
        LAS unsigned char* slot = kring + (t & 1) * (128 * VSTR);
        if (MODE != 3 && t + 1 < ntile) { rk = *(const v4u*)(Kg + (size_t)(t + 1) * 4096 + tid * 8); rv = *(const v4u*)(Vg + (size_t)(t + 1) * 4096 + tid * 8); }
        const int kb = t >> 2, j = t & 3;
        const bool own = (kb == qb);
        const bool sel = own || ((selmask >> kb) & 1u);
        const bool need = own ? (2 * j <= F.wave) : (__any(sel) != 0);
        if (need && MODE != 2) {
            const int tk0 = kb * 256 + 64 * j;
            f32x16 s[2];
            bf16x8 k0[4], k1[4];
            { const LAS unsigned char* kp = slot + qi * VSTR + 16 * hi;
#pragma unroll
              for (int ks = 0; ks < 4; ++ks) { k0[ks] = *(const LAS bf16x8*)(kp + 32 * ks); k1[ks] = *(const LAS bf16x8*)(kp + 32 * VSTR + 32 * ks); }
              const LAS float* tp = tabk + (sel ? ybase + tk0 : 2048);
              s[0] = at_bias(tp); s[1] = at_bias(tp + 32); }
            __builtin_amdgcn_sched_barrier(0);
#pragma unroll
            for (int ks = 0; ks < 4; ++ks) {
                s[0] = __builtin_amdgcn_mfma_f32_32x32x16_bf16(k0[ks], qf[ks], s[0], 0, 0, 0);
                s[1] = __builtin_amdgcn_mfma_f32_32x32x16_bf16(k1[ks], qf[ks], s[1], 0, 0, 0);
            }
            __builtin_amdgcn_sched_barrier(0);
            at_step<2>(T, s, slot + 64 * VSTR, lane);
        }
        if (t + 1 < ntile) { LAS unsigned char* nslot = kring + ((t + 1) & 1) * (128 * VSTR); *(LAS v4u*)(nslot + soff) = rk; *(LAS v4u*)(nslot + 64 * VSTR + soff) = rv; }
        __syncthreads();
    }
    const float ltot = T.ls[0];
    if (MODE != 0) { asm volatile("" :: "v"(T.o0), "v"(T.o1), "v"(ltot)); return; }
    { const size_t q0 = rowb + tq0; at_store_gated(T, 1.0f / ltot, PHEAD(24 + h) + q0 * HD, F_BR + q0 * BRP + 0 * WBR + h * 64, F.lds + AT_VT + F.wave * AT_VT_WAVE, lane); }
}

constexpr int TABS = 208;
__device__ __forceinline__ void swa_unit(Frame& F, int b, int spn, int hq, const float* sinks_l) {
    LAS float* tab4 = (LAS float*)(F.lds + AT_TAB);
    LAS unsigned char* vt = F.lds + AT_VT + F.wave * AT_VT_WAVE;
    const int lane = F.lane, qi = lane & 31, hi = lane >> 5;
    __syncthreads();
    for (int i = F.tid; i < 4 * TABS; i += NWAVES * 64) { const int k = i / TABS, y = i % TABS + k, dlt = 160 - y; tab4[i] = (dlt >= 0 && dlt < 128) ? F_BIAS[(OFF_C + hq) * SEQ + dlt] : -INFINITY; }
    __syncthreads();
    const int tq0 = spn * 256 + 32 * F.wave, kvh = hq >> 2;
    const size_t rowb = (size_t)b * SEQ, qrow = rowb + tq0 + qi;
    bf16x8 qf[4];
#pragma unroll
    for (int ks = 0; ks < 4; ++ks) qf[ks] = *(const bf16x8*)(PHEAD(112 + hq) + qrow * HD + 16 * ks + 8 * hi);
    const bf16* Kg = PHEAD(120 + kvh) + rowb * HD; const bf16* Vg = PHEAD(122 + kvh) + rowb * HD;
    int kt0 = 4 - (tq0 >> 5); kt0 = kt0 < 0 ? 0 : kt0;
    const int kcopy = (0 - qi) & 3;
    const LAS float* tabk = tab4 + kcopy * TABS + (32 - qi + 4 * hi - kcopy);
    ATile T; T.init();
    KVregs A; { const int tk0 = tq0 - 128 + 32 * kt0; at_load_kv(A, Kg + (size_t)tk0 * HD, Vg + (size_t)tk0 * HD, lane); }
    for (int kt = kt0; kt < 5; ++kt) {
        KVregs Bn; { const int ktn = kt + 1 < 5 ? kt + 1 : 4; const int tkn = tq0 - 128 + 32 * ktn; at_load_kv(Bn, Kg + (size_t)tkn * HD, Vg + (size_t)tkn * HD, lane); }
        at_stage_v(A.vr, vt, lane);
        f32x16 s[1]; s[0] = at_bias(tabk + 32 * kt);
        __builtin_amdgcn_sched_barrier(0);
#pragma unroll
        for (int ks = 0; ks < 4; ++ks) s[0] = __builtin_amdgcn_mfma_f32_32x32x16_bf16(A.kf[ks], qf[ks], s[0], 0, 0, 0);
        at_step<1>(T, s, vt, lane);
        A = Bn;
    }
    const float sk = sinks_l[hq] * LOG2E;
    const float ltot = T.ls[0] + __builtin_amdgcn_exp2f(sk);
    { const size_t q0 = rowb + tq0; at_store_gated(T, 1.0f / ltot, PHEAD(124 + hq) + q0 * HD, F_BR + q0 * BRP + 2 * WBR + hq * 64, vt, lane); }
}

template <int MODE> __device__ __forceinline__ void dil_unit(Frame& F, int b, int h, int sp) {
    LAS float* tab4 = (LAS float*)(F.lds + AT_TAB);
    LAS unsigned char* vt = F.lds + AT_VT + F.wave * AT_VT_WAVE;
    const int lane = F.lane, qi = lane & 31, hi = lane >> 5;
    const size_t rowb = (size_t)b * SEQ;
    __syncthreads();
    for (int i = F.tid; i < 3 * 4 * TABS; i += NWAVES * 64) { const int g = i / (4 * TABS), k = (i / TABS) & 3, y = i % TABS + k, dlt = 160 - y, dil = 1 << (2 * g);
        tab4[i] = (dlt >= 0 && dlt <= 128) ? F_BIAS[(OFF_B + g * 8 + h) * SEQ + (dil * dlt > 2047 ? 2047 : dil * dlt)] : -INFINITY; }
    __syncthreads();
    const int kcopy = (0 - qi) & 3;
    for (int g = 0; g < 3; ++g) {
        const int dsh = 2 * g, dil = 1 << dsh;
        for (int t2 = 0; t2 < 2; ++t2) {
            const int tt = 2 * F.wave + t2;
            int res, pq0, nkt, pkb;
            if (g == 0)      { res = 0;       pq0 = 512 * sp + 32 * tt;       nkt = 5;      pkb = pq0 - 128; }
            else if (g == 1) { res = tt >> 2; pq0 = 128 * sp + 32 * (tt & 3); nkt = 5;      pkb = pq0 - 128; }
            else             { res = tt;      pq0 = 32 * sp;                  nkt = sp + 1; pkb = 0; }
            int kt0 = (pkb < 0) ? ((-pkb) >> 5) : 0;
            const int pq = pq0 + qi;
            const size_t rbase = rowb + (size_t)res * (SEQ >> dsh);
            bf16x8 qf[4];
#pragma unroll
            for (int ks = 0; ks < 4; ++ks) qf[ks] = *(const bf16x8*)(PHEAD(32 + g * 8 + h) + (rbase + pq) * HD + 16 * ks + 8 * hi);
            const bf16* Kg = PHEAD(56 + g * 8 + h) + rbase * HD; const bf16* Vg = PHEAD(80 + g * 8 + h) + rbase * HD;
            const LAS float* tabk = tab4 + (g * 4 + kcopy) * TABS + (160 - (pq0 - pkb) - qi + 4 * hi - kcopy);
            ATile T; T.init();
            KVregs A; { const int pk0 = pkb + 32 * kt0; at_load_kv(A, Kg + (size_t)pk0 * HD, Vg + (size_t)pk0 * HD, lane); }
            for (int kt = kt0; kt < nkt; ++kt) {
                KVregs Bn; if (MODE != 3) { const int ktn = kt + 1 < nkt ? kt + 1 : nkt - 1; const int pkn = pkb + 32 * ktn; at_load_kv(Bn, Kg + (size_t)pkn * HD, Vg + (size_t)pkn * HD, lane); } else Bn = A;
                if (MODE == 2) { asm volatile("" :: "v"(A.kf[0]), "v"(A.kf[1]), "v"(A.kf[2]), "v"(A.kf[3]), "v"(A.vr[0]), "v"(A.vr[1]), "v"(A.vr[2]), "v"(A.vr[3])); A = Bn; continue; }
                at_stage_v(A.vr, vt, lane);
                f32x16 s[1]; s[0] = at_bias(tabk + 32 * kt);
                __builtin_amdgcn_sched_barrier(0);
#pragma unroll
                for (int ks = 0; ks < 4; ++ks) s[0] = __builtin_amdgcn_mfma_f32_32x32x16_bf16(A.kf[ks], qf[ks], s[0], 0, 0, 0);
                at_step<1>(T, s, vt, lane);
                A = Bn;
            }
            const float ltot = T.ls[0];
            const float inv = 1.0f / ltot;
            if (MODE != 0) { asm volatile("" :: "v"(T.o0), "v"(T.o1), "v"(inv)); continue; }
            const size_t obase = ((size_t)(g * BATCH + b) * 8 + h) * SEQ;
            const size_t orow = obase + (size_t)(dil * pq + res);
            at_stage_o(T, inv, vt, lane);
#pragma unroll
            for (int i = 0; i < 4; ++i) { const int r = 8 * i + (lane >> 3), ch = lane & 7;
                *(v4u*)(F_OG + (obase + (size_t)(dil * (pq0 + r) + res)) * HD + ch * 8) = *(const LAS v4u*)(vt + r * VSTR + ch * 16); }
            asm volatile("" ::: "memory");
            if (hi == 0) F_LSE[orow] = __builtin_amdgcn_logf(ltot);
        }
    }
    VM_WAIT(); __syncthreads();
    if (MODE == 0) {
        const int ch = F.tid & 7;
#pragma unroll 2
        for (int i = 0; i < 8; ++i) {
            const int tok = 512 * sp + 64 * i + (F.tid >> 3);
            const size_t o0r = ((size_t)(0 * BATCH + b) * 8 + h) * SEQ + tok, o1r = ((size_t)(1 * BATCH + b) * 8 + h) * SEQ + tok, o2r = ((size_t)(2 * BATCH + b) * 8 + h) * SEQ + tok;
            const float l0 = F_LSE[o0r], l1 = F_LSE[o1r], l2 = F_LSE[o2r];
            const v4u a = *(const v4u*)(F_OG + o0r * HD + ch * 8), bq = *(const v4u*)(F_OG + o1r * HD + ch * 8), cq = *(const v4u*)(F_OG + o2r * HD + ch * 8);
            const size_t row = rowb + tok;
            const v4u gg = *(const v4u*)(PHEAD(104 + h) + row * HD + ch * 8);
            const float mx = fmaxf(l0, fmaxf(l1, l2));
            float w0 = __builtin_amdgcn_exp2f(l0 - mx), w1 = __builtin_amdgcn_exp2f(l1 - mx), w2 = __builtin_amdgcn_exp2f(l2 - mx);
            const float inv = 1.0f / (w0 + w1 + w2); w0 *= inv; w1 *= inv; w2 *= inv;
            v4u w;
            w.x = cvt_pk_bf16((w0 * bf_lo(a.x) + w1 * bf_lo(bq.x) + w2 * bf_lo(cq.x)) * bf_lo(gg.x), (w0 * bf_hi(a.x) + w1 * bf_hi(bq.x) + w2 * bf_hi(cq.x)) * bf_hi(gg.x));
            w.y = cvt_pk_bf16((w0 * bf_lo(a.y) + w1 * bf_lo(bq.y) + w2 * bf_lo(cq.y)) * bf_lo(gg.y), (w0 * bf_hi(a.y) + w1 * bf_hi(bq.y) + w2 * bf_hi(cq.y)) * bf_hi(gg.y));
            w.z = cvt_pk_bf16((w0 * bf_lo(a.z) + w1 * bf_lo(bq.z) + w2 * bf_lo(cq.z)) * bf_lo(gg.z), (w0 * bf_hi(a.z) + w1 * bf_hi(bq.z) + w2 * bf_hi(cq.z)) * bf_hi(gg.z));
            w.w = cvt_pk_bf16((w0 * bf_lo(a.w) + w1 * bf_lo(bq.w) + w2 * bf_lo(cq.w)) * bf_lo(gg.w), (w0 * bf_hi(a.w) + w1 * bf_hi(bq.w) + w2 * bf_hi(cq.w)) * bf_hi(gg.w));
            *(v4u*)(F_BR + row * BRP + 1 * WBR + h * 64 + ch * 8) = w;
        }
    }
}

__device__ __forceinline__ void attn_phase(Frame& F0, int layer) {
    Frame F = F0; asm volatile("" : "+v"(F.tid), "+v"(F.lane));
    if (DBG_TWICE & 4) for (int u = F.vcu; u < 256; u += F.G) { const int bh = u >> 2, pr = u & 3; moba_unit<DBG_MODE>(F, bh >> 3, bh & 7, pr); moba_unit<DBG_MODE>(F, bh >> 3, bh & 7, 7 - pr); }
    for (int u = F.vcu; u < 256; u += F.G) { const int bh = u >> 2, pr = u & 3; moba_unit<0>(F, bh >> 3, bh & 7, pr); moba_unit<0>(F, bh >> 3, bh & 7, 7 - pr); }
    if (DBG_TWICE & 8) for (int u = F.vcu; u < 256; u += F.G) { const int bh = u >> 2, sp = u & 3; dil_unit<DBG_MODE>(F, bh >> 3, bh & 7, sp); }
    for (int u = F.vcu; u < 256; u += F.G) { const int bh = u >> 2, sp = u & 3; dil_unit<0>(F, bh >> 3, bh & 7, sp); }
    for (int rep = 0; rep < ((DBG_TWICE & 16) ? 2 : 1); ++rep)
    for (int u = F.vcu; u < 512; u += F.G) { const int hq = u & 7, spn = (u >> 3) & 7, b = u >> 6; swa_unit(F, b, spn, hq, F_SINK + layer * 8); }
    __syncthreads();
}

struct Args { const float* in[8]; float* out; unsigned char* ws; int ph_lo, ph_hi; };
__global__ void __launch_bounds__(NWAVES * 64, 2) trunk_fwd(Args args) {
    extern __shared__ __attribute__((aligned(16))) unsigned char lds[];
    Frame F;
    F.lds = (LAS unsigned char*)lds;
    F.tid = threadIdx.x; F.lane = F.tid & 63; F.wave = __builtin_amdgcn_readfirstlane(F.tid >> 6);
    F.G = gridDim.x; { const int bx = blockIdx.x; F.vcu = (F.G % 8 == 0) ? (bx % 8) * (F.G / 8) + bx / 8 : bx; }
    unsigned char* ws = args.ws;
    F.x = args.in[0]; F.ws = ws;
    F.out = args.out;
    for (int u = F.tid; u < (LDS_BYTES - LDSCTL_OFF) / 4; u += NWAVES * 64) ((LAS unsigned*)(F.lds + LDSCTL_OFF))[u] = 0u;
    __syncthreads();
    XcdBarrier bar; bar.bar = (unsigned*)(ws + WS_CTL) + CW_BAR; bar.x = 0; bar.st = nullptr;
    if (!MK_PER_PHASE) bar = xcd_barrier_post((unsigned*)(ws + WS_CTL) + CW_BAR, (volatile LAS unsigned*)(F.lds + MISC_OFF) + 8);
    const int lo = args.ph_lo, hi = args.ph_hi;
#define IN(k) (lo <= (k) && (k) < hi)
#define SEAM(k) do { if (IN(k) && IN((k) + 1)) xcd_barrier(bar); } while (0)
    if (IN(0) && (DBG_PH & 1)) { for (int rep = 0; rep < ((DBG_TWICE & 1) ? 2 : 1); ++rep) p0_prologue(F, args.in[1], args.in[2], args.in[3], args.in[4], args.in[5], args.in[6], args.in[7]); SEAM(0); }
    for (int l = 0; l < DEPTH; ++l) {
        const int p1 = 1 + 4 * l;
        if (IN(p1) && (DBG_PH & 2)) {
            pg8::Gemm g{F_XB, F_WINT + (size_t)l * CIN * DM, M, CIN, DM}; pg8::StaticOrder S; S.init(M, CIN, F.G, (int)blockIdx.x);
            pg8::EpiProj E{F_P, F_SSQ, F_QKG + l * 6 * HD, F_KM};
            if (G1_STAGGER_TICKS > 0) {
                if (F.tid == 0) { const unsigned long long t0 = __builtin_amdgcn_s_memrealtime(), dt = (unsigned long long)(((unsigned)blockIdx.x >> 3) & 3u) * G1_STAGGER_TICKS;
                    while (__builtin_amdgcn_s_memrealtime() - t0 < dt) __builtin_amdgcn_s_sleep(8); }
                __syncthreads();
            }
            if (DBG_TWICE & 128) { pg8::EpiProjT<false> EN{F_P, F_SSQ, F_QKG + l * 6 * HD, F_KM}; pg8::gemm_phase<pg8::EpiProjT<false>, pg8::StaticOrder, true, true>(F.lds + RING_OFF, g, S, EN); }
            if (DBG_TWICE & 64) { pg8::EpiNull EN; pg8::gemm_phase<pg8::EpiNull, pg8::StaticOrder, true, true>(F.lds + RING_OFF, g, S, EN); }
            for (int rep = 0; rep < ((DBG_TWICE & 2) ? 2 : 1); ++rep) pg8::gemm_phase<pg8::EpiProj, pg8::StaticOrder, true, true>(F.lds + RING_OFF, g, S, E);
            SEAM(p1);
        }
        if (IN(p1 + 1) && (DBG_PH & 4)) { attn_phase(F, l); SEAM(p1 + 1); }
        if (IN(p1 + 2) && (DBG_PH & 8)) {
            pg8::Gemm g{F_BR, F_WBRT + (size_t)l * DM * BRP, M, DM, BRP}; pg8::StaticOrder S; S.init(M, DM, F.G, (int)blockIdx.x);
            pg8::EpiMerge E{F_P, F_MG};
            if (DBG_TWICE & 256) { pg8::EpiNull EN; pg8::gemm_phase<pg8::EpiNull, pg8::StaticOrder, true, true>(F.lds + RING_OFF, g, S, EN); }
            for (int rep = 0; rep < ((DBG_TWICE & 32) ? 2 : 1); ++rep) pg8::gemm_phase<pg8::EpiMerge, pg8::StaticOrder, true, true>(F.lds + RING_OFF, g, S, E);
            SEAM(p1 + 2);
        }
        if (IN(p1 + 3) && (DBG_PH & 16)) {
            pg8::Gemm g{F_MG, F_WOUTT + (size_t)l * DM * DM, M, DM, DM}; pg8::StaticOrder S; S.init(M, DM, F.G, (int)blockIdx.x);
            pg8::EpiRes E{l == 0 ? F.x : F.out, F.out, F_XB, F_SSQ};
            pg8::gemm_phase<pg8::EpiRes, pg8::StaticOrder, false, true>(F.lds + RING_OFF, g, S, E);
            if (l + 1 < DEPTH) SEAM(p1 + 3);
        }
    }
#undef IN
#undef SEAM
}

extern "C" void kernel_launch(void* const* d_in, const int* in_sizes, int n_in, void* d_out, int out_size, void* d_ws, size_t ws_size, hipStream_t stream) {
    static int grid = 0;
    if (grid == 0) {
        if (n_in != 8 || in_sizes[0] != M * DM || out_size != M * DM || ws_size < WS_END) { fprintf(stderr, "kernel_launch: unexpected shapes (n_in %d, in0 %d, out %d, ws %zu need %zu); nothing launched\n", n_in, n_in > 0 ? in_sizes[0] : -1, out_size, ws_size, (size_t)WS_END); grid = -1; return; }
        int dev = 0, cus = 0, per_cu = 0;
        if (hipGetDevice(&dev) != hipSuccess || hipDeviceGetAttribute(&cus, hipDeviceAttributeMultiprocessorCount, dev) != hipSuccess) { fprintf(stderr, "kernel_launch: device query failed\n"); grid = -1; return; }
        if (hipFuncSetAttribute((const void*)trunk_fwd, hipFuncAttributeMaxDynamicSharedMemorySize, LDS_BYTES) != hipSuccess) { fprintf(stderr, "kernel_launch: hipFuncSetAttribute failed\n"); grid = -1; return; }
        if (hipOccupancyMaxActiveBlocksPerMultiprocessor(&per_cu, (const void*)trunk_fwd, NWAVES * 64, LDS_BYTES) != hipSuccess || per_cu < 1) fprintf(stderr, "kernel_launch: note: occupancy query reports %d workgroups per CU\n", per_cu);
        (void)hipGetLastError();
        grid = cus;
    }
    if (grid < 0) return;
    if (hipMemsetAsync((char*)d_ws + WS_CTL, 0, CTL_ZERO_BYTES, stream) != hipSuccess) { fprintf(stderr, "kernel_launch: memset failed\n"); return; }
    Args a{};
    for (int i = 0; i < 8; ++i) a.in[i] = (const float*)d_in[i];
    a.out = (float*)d_out; a.ws = (unsigned char*)d_ws;
#if MK_PER_PHASE
    for (int p = 0; p < N_PHASES; ++p) { a.ph_lo = p; a.ph_hi = p + 1; hipLaunchKernelGGL(trunk_fwd, dim3(grid), dim3(NWAVES * 64), LDS_BYTES, stream, a); }
#else
    a.ph_lo = 0; a.ph_hi = N_PHASES;
    hipLaunchKernelGGL(trunk_fwd, dim3(grid), dim3(NWAVES * 64), LDS_BYTES, stream, a);
#endif
    const hipError_t le = hipPeekAtLastError();
    if (le != hipSuccess) fprintf(stderr, "kernel_launch: launch failed: %s\n", hipGetErrorName(le));
}
```

```cpp
#include <hip/hip_runtime.h>
#include <cstdio>
#include <cstdint>

#ifndef DBG_PH
#define DBG_PH 31
#endif
#ifndef DBG_TWICE
#define DBG_TWICE 0
#endif
#ifndef G1_STAGGER_TICKS
#define G1_STAGGER_TICKS 0
#endif
#ifndef DBG_MODE
#define DBG_MODE 0
#endif
#ifndef MK_PER_PHASE
#define MK_PER_PHASE 0
#endif

constexpr int BATCH = 8, SEQ = 2048, DM = 1024, DEPTH = 4, HD = 64, WBR = 512;
constexpr int M = BATCH * SEQ;
constexpr int CIN = 11520;
constexpr int NBUCK = 32, NH_TOT = 40, OFF_A = 0, OFF_B = 8, OFF_C = 32;
constexpr int C_QA = 0, C_KA = 512, C_VA = 1024, C_GA = 1536, C_QB = 2048, C_KB = 3584, C_VB = 5120, C_GB = 6656, C_QC = 7168, C_KC = 7680, C_VC = 7808, C_GC = 7936, C_GL = 8448;
constexpr float LOG2E = 1.4426950408889634f;
constexpr float C2 = 0.125f * LOG2E;
constexpr float EPS = 1e-6f;
constexpr int NHEADS = 132;
constexpr size_t GL_OFF = (size_t)NHEADS * 16384 * 64;
constexpr int BRP = 3 * WBR;

namespace pg8 {
#define PG8_LAS __attribute__((address_space(3)))
typedef unsigned short bf16_t;
typedef short bf16x8 __attribute__((ext_vector_type(8)));
typedef float f32x4 __attribute__((ext_vector_type(4)));
typedef unsigned u32x4 __attribute__((ext_vector_type(4)));
typedef unsigned u32x2 __attribute__((ext_vector_type(2)));
constexpr int BM = 256, BK = 64, HALF = 128, HTB = HALF * BK * 2, STAGE_BYTES = 8 * HTB, NXCD = 8, WGM = 8;

__host__ __device__ __forceinline__ int lds_byte(int r, int c) { const int st = (r >> 4) * 2 + (c >> 5), rr = r & 15, cc = c & 31, ob = rr * 64 + cc * 2; return st * 1024 + (ob ^ (((ob >> 9) & 1) << 5)); }
__host__ __device__ __forceinline__ void stage_rc(int b, int& R, int& C) { const int st = b / 1024, sb = b % 1024, swz = sb ^ (((sb >> 9) & 1) << 5); R = (st >> 1) * 16 + swz / 64; C = (st & 1) * 32 + (swz % 64) / 2; }
__host__ __device__ __forceinline__ int perm32(int rho) { const int n = rho >> 4, i = rho & 15; return 8 * (i >> 2) + 4 * n + (i & 3); }

struct Unit { int pm, pn; };
struct Gemm { const bf16_t* A; const bf16_t* Bt; int M, N, K; };

struct StaticOrder {
    int nM, nN, nwg, G, c;
    __host__ __device__ void init(int M_, int N_, int G_, int c_) { nM = M_ / BM; nN = N_ / BM; nwg = nM * nN; G = G_; c = c_; }
    __host__ __device__ bool next(int i, Unit& u) const {
        const long L = (long)i * G + c; if (L >= nwg) return false;
        int wgid = (int)L; { const int q = nwg / NXCD, r = nwg % NXCD, xcd = wgid % NXCD, off = wgid / NXCD; wgid = (xcd < r ? xcd * (q + 1) : r * (q + 1) + (xcd - r) * q) + off; }
        const int nig = WGM * nN, gid = wgid / nig, fm = gid * WGM, gsz = (nM - fm) < WGM ? (nM - fm) : WGM;
        u.pm = fm + ((wgid % nig) % gsz); u.pn = (wgid % nig) / gsz; return true;
    }
    __device__ __forceinline__ void a_ready(const Unit&) const {}
    __device__ __forceinline__ void done(const Unit&) const {}
};

typedef float f32x2 __attribute__((ext_vector_type(2)));
typedef __bf16 bf16x2_t __attribute__((ext_vector_type(2)));
__device__ __forceinline__ unsigned cvt_pk_bf16(float lo, float hi) { f32x2 v = {lo, hi}; bf16x2_t b = __builtin_convertvector(v, bf16x2_t); return __builtin_bit_cast(unsigned, b); }
__device__ __forceinline__ float bf_lo(unsigned w) { return __builtin_bit_cast(float, w << 16); }
__device__ __forceinline__ float bf_hi(unsigned w) { return __builtin_bit_cast(float, w & 0xffff0000u); }

template <class Epi, class Sched, bool ALIGN_EPI = false, bool SP2 = false>
__device__ __forceinline__ void gemm_phase(PG8_LAS unsigned char* lds, const Gemm g, const Sched& S, const Epi& E) {
    int tid_ = threadIdx.x; asm volatile("" : "+v"(tid_));
    const int tid = tid_, wid = __builtin_amdgcn_readfirstlane(tid >> 6), lane = tid & 63, wr = wid >> 2, wc = wid & 3, fr = lane & 15, fq = lane >> 4;
    const int K = g.K, nt = K / BK;
    unsigned voffA[2], voffB[2];
#pragma unroll
    for (int i = 0; i < 2; ++i) { int R, C; stage_rc(tid * 16 + i * 8192, R, C); const int Rb = Epi::PERM ? ((R & ~31) + perm32(R & 31)) : R;
        voffA[i] = (unsigned)(R * K + C) * 2u; voffB[i] = (unsigned)(Rb * K + C) * 2u; }
    const size_t kstep = (size_t)(BK * 2);
    const size_t hstep = (size_t)HALF * K * 2;
    const size_t tstep = 2 * hstep;
    const unsigned ldsw = (unsigned)wid * 1024u;
    const int aoff = lds_byte(wr * 64 + fr, fq * 8), boff = lds_byte(wc * 32 + fr, fq * 8);
#define PG8_SA(b, h) (((b) * 2 + (h)) * HTB)
#define PG8_SB(b, h) ((4 + (b) * 2 + (h)) * HTB)
#define PG8_STAGE(bufoff, gbase, voff) do { _Pragma("unroll") for (int _i = 0; _i < 2; ++_i) \
        __builtin_amdgcn_global_load_lds((const unsigned*)((const char*)(gbase) + (voff)[_i]), (PG8_LAS unsigned*)(lds + (bufoff) + ldsw + _i * 8192), 16, 0, 0); } while (0)
#define PG8_LDA(dst, b, h) do { _Pragma("unroll") for (int m = 0; m < 4; ++m) _Pragma("unroll") for (int k = 0; k < 2; ++k) dst[m][k] = *(const PG8_LAS bf16x8*)(lds + PG8_SA(b, h) + aoff + m * 2048 + k * 1024); } while (0)
#define PG8_LDB(dst, b, h) do { _Pragma("unroll") for (int n = 0; n < 2; ++n) _Pragma("unroll") for (int k = 0; k < 2; ++k) dst[n][k] = *(const PG8_LAS bf16x8*)(lds + PG8_SB(b, h) + boff + n * 2048 + k * 1024); } while (0)
#define PG8_MMA(ai, bj, At, Bt) do { __builtin_amdgcn_s_setprio(1); _Pragma("unroll") for (int m = 0; m < 4; ++m) _Pragma("unroll") for (int n = 0; n < 2; ++n) _Pragma("unroll") for (int k = 0; k < 2; ++k) \
        acc[ai][bj][m][n] = __builtin_amdgcn_mfma_f32_16x16x32_bf16(Bt[n][k], At[m][k], acc[ai][bj][m][n], 0, 0, 0); __builtin_amdgcn_s_setprio(0); } while (0)
#define PG8_WAIT_V(n) asm volatile("s_waitcnt vmcnt(" #n ")" ::: "memory")
#define PG8_WAIT_L(n) asm volatile("s_waitcnt lgkmcnt(" #n ")" ::: "memory")
#define PG8_BAR __builtin_amdgcn_s_barrier()
#define PG8_SCHED __builtin_amdgcn_sched_barrier(0)
    Unit cur, nxt; int ui = 0;
    if (!S.next(0, cur)) return;
    f32x4 acc[2][2][4][2];
#pragma unroll
    for (int a = 0; a < 2; ++a)
#pragma unroll
        for (int b = 0; b < 2; ++b)
#pragma unroll
            for (int m = 0; m < 4; ++m)
#pragma unroll
                for (int n = 0; n < 2; ++n) acc[a][b][m][n] = (f32x4){0.f, 0.f, 0.f, 0.f};
    bf16x8 At[4][2], B0[2][2], B1[2][2];
    const char* cA = (const char*)g.A + (size_t)cur.pm * tstep; const char* cB = (const char*)g.Bt + (size_t)cur.pn * tstep;
    S.a_ready(cur);
    if constexpr (SP2) {
        PG8_STAGE(PG8_SB(0, 0), cB, voffB); PG8_STAGE(PG8_SB(0, 1), cB + hstep, voffB); PG8_STAGE(PG8_SA(0, 0), cA, voffA); PG8_STAGE(PG8_SA(0, 1), cA + hstep, voffA);
        if (wr == 1) PG8_BAR;
        PG8_WAIT_V(2); PG8_BAR;
        PG8_STAGE(PG8_SB(1, 0), cB + kstep, voffB); PG8_STAGE(PG8_SA(1, 0), cA + kstep, voffA); PG8_STAGE(PG8_SB(1, 1), cB + hstep + kstep, voffB);
        PG8_WAIT_V(6); PG8_BAR;
    } else {
        PG8_STAGE(PG8_SB(0, 0), cB, voffB); PG8_STAGE(PG8_SA(0, 0), cA, voffA); PG8_STAGE(PG8_SB(0, 1), cB + hstep, voffB); PG8_STAGE(PG8_SA(0, 1), cA + hstep, voffA);
        if (wr == 1) PG8_BAR;
        PG8_WAIT_V(4); PG8_BAR;
        PG8_STAGE(PG8_SB(1, 0), cB + kstep, voffB); PG8_STAGE(PG8_SA(1, 0), cA + kstep, voffA); PG8_STAGE(PG8_SB(1, 1), cB + hstep + kstep, voffB);
        PG8_WAIT_V(6); PG8_BAR;
    }
    for (;;) {
        const bool has_next = S.next(ui + 1, nxt);
        const char* nA = has_next ? (const char*)g.A + (size_t)nxt.pm * tstep : cA; const char* nB = has_next ? (const char*)g.Bt + (size_t)nxt.pn * tstep : cB;
        for (int t = 0; t < nt; t += 2) {
            const bool last = (t == nt - 2);
            const char* a1 = cA + (size_t)(t + 1) * kstep;
            const char* a2 = last ? nA : cA + (size_t)(t + 2) * kstep; const char* b2 = last ? nB : cB + (size_t)(t + 2) * kstep;
            const char* a3 = a2 + kstep; const char* b3 = b2 + kstep;
            if (last && has_next) S.a_ready(nxt);
            if constexpr (Epi::PREFETCH) E.prefetch(cur, t, tid, lds + STAGE_BYTES + 1024 + wid * 256);
            if constexpr (Epi::MIDHOOK) { if (t == 8 || t == 16) E.mid(acc, cur, t >> 3, wr, wc, fr, fq); }
            if constexpr (SP2) {
            PG8_LDB(B0, 0, 0); PG8_LDB(B1, 0, 1); PG8_SCHED; PG8_LDA(At, 0, 0); PG8_STAGE(PG8_SA(1, 1), a1 + hstep, voffA);
            PG8_WAIT_V(8); PG8_WAIT_L(0); PG8_BAR; PG8_MMA(0, 0, At, B0); PG8_MMA(0, 1, At, B1); PG8_BAR; PG8_SCHED;
            PG8_LDA(At, 0, 1); PG8_STAGE(PG8_SB(0, 0), b2, voffB); PG8_STAGE(PG8_SB(0, 1), b2 + hstep, voffB); PG8_STAGE(PG8_SA(0, 0), a2, voffA);
            PG8_WAIT_V(8); PG8_WAIT_L(0); PG8_BAR; PG8_MMA(1, 0, At, B0); PG8_MMA(1, 1, At, B1); PG8_BAR; PG8_SCHED;
            PG8_LDB(B0, 1, 0); PG8_LDB(B1, 1, 1); PG8_SCHED; PG8_LDA(At, 1, 0); PG8_STAGE(PG8_SA(0, 1), a2 + hstep, voffA);
            PG8_WAIT_V(8); PG8_WAIT_L(0); PG8_BAR; PG8_MMA(0, 0, At, B0); PG8_MMA(0, 1, At, B1); PG8_BAR; PG8_SCHED;
            PG8_LDA(At, 1, 1); PG8_STAGE(PG8_SB(1, 0), b3, voffB); PG8_STAGE(PG8_SB(1, 1), b3 + hstep, voffB); PG8_STAGE(PG8_SA(1, 0), a3, voffA);
            PG8_WAIT_V(8); PG8_WAIT_L(0); PG8_BAR; PG8_MMA(1, 0, At, B0); PG8_MMA(1, 1, At, B1); PG8_BAR; PG8_SCHED;
            } else {
            PG8_LDB(B0, 0, 0); PG8_SCHED; PG8_LDA(At, 0, 0); PG8_STAGE(PG8_SA(1, 1), a1 + hstep, voffA);
            PG8_WAIT_L(8); PG8_BAR; PG8_WAIT_L(0); PG8_MMA(0, 0, At, B0); PG8_BAR; PG8_SCHED;
            PG8_LDB(B1, 0, 1); PG8_STAGE(PG8_SB(0, 0), b2, voffB);
            PG8_BAR; PG8_WAIT_L(0); PG8_MMA(0, 1, At, B1); PG8_BAR;
            PG8_LDA(At, 0, 1); PG8_STAGE(PG8_SA(0, 0), a2, voffA);
            PG8_BAR; PG8_WAIT_L(0); PG8_MMA(1, 0, At, B0); PG8_BAR; PG8_SCHED;
            PG8_STAGE(PG8_SB(0, 1), b2 + hstep, voffB);
            PG8_WAIT_V(6); PG8_BAR; PG8_MMA(1, 1, At, B1); PG8_BAR;
            PG8_LDB(B0, 1, 0); PG8_SCHED; PG8_LDA(At, 1, 0); PG8_STAGE(PG8_SA(0, 1), a2 + hstep, voffA);
            PG8_WAIT_L(8); PG8_BAR; PG8_WAIT_L(0); PG8_MMA(0, 0, At, B0); PG8_BAR; PG8_SCHED;
            PG8_LDB(B1, 1, 1); PG8_STAGE(PG8_SB(1, 0), b3, voffB);
            PG8_BAR; PG8_WAIT_L(0); PG8_MMA(0, 1, At, B1); PG8_BAR;
            PG8_LDA(At, 1, 1); PG8_STAGE(PG8_SA(1, 0), a3, voffA);
            PG8_BAR; PG8_WAIT_L(0); PG8_MMA(1, 0, At, B0); PG8_BAR; PG8_SCHED;
            PG8_STAGE(PG8_SB(1, 1), b3 + hstep, voffB);
            PG8_WAIT_V(6); PG8_BAR; PG8_MMA(1, 1, At, B1); PG8_BAR;
            }
        }
        if constexpr (ALIGN_EPI) { if (wr == 0) PG8_BAR; }
        if constexpr (!Epi::AFTER_DRAIN) { E(acc, cur, wr, wc, fr, fq); S.done(cur); }
        if (!has_next) break;
#pragma unroll
        for (int a = 0; a < 2; ++a)
#pragma unroll
            for (int b = 0; b < 2; ++b)
#pragma unroll
                for (int m = 0; m < 4; ++m)
#pragma unroll
                    for (int n = 0; n < 2; ++n) acc[a][b][m][n] = (f32x4){0.f, 0.f, 0.f, 0.f};
        cur = nxt; cA = nA; cB = nB; ++ui;
        if constexpr (ALIGN_EPI) { if (wr == 1) PG8_BAR; }
    }
    PG8_WAIT_V(0);
    if constexpr (!ALIGN_EPI) { if (wr == 0) PG8_BAR; }
    PG8_BAR;
    if constexpr (Epi::AFTER_DRAIN) { E.fused(acc, cur, wr, wc, fr, fq, lds, wid, lane); S.done(cur); }
#undef PG8_SA
#undef PG8_SB
#undef PG8_STAGE
#undef PG8_LDA
#undef PG8_LDB
#undef PG8_MMA
#undef PG8_WAIT_V
#undef PG8_WAIT_L
#undef PG8_BAR
#undef PG8_SCHED
}

__device__ __forceinline__ void swap16(float x, float& a, float& b) { a = x; b = x; asm volatile("v_nop\n\tv_nop\n\tv_permlane16_swap_b32 %0, %1" : "+v"(a), "+v"(b)); }
__device__ __forceinline__ void swap32(float x, float& a, float& b) { a = x; b = x; asm volatile("v_nop\n\tv_nop\n\tv_permlane32_swap_b32 %0, %1" : "+v"(a), "+v"(b)); }
__device__ __forceinline__ float xrow16_sum(float x) {
    float a, b; swap16(x, a, b); x = a + b; swap32(x, a, b); return a + b;
}
__device__ __forceinline__ float xhalf_max(float x) { float a, b; swap32(x, a, b); return fmaxf(a, b); }
__device__ __forceinline__ float fast_sigmoid(float v) { return __builtin_amdgcn_rcpf(1.0f + __builtin_amdgcn_exp2f(-v * LOG2E)); }

template <bool STORE = true> struct EpiProjT {
    static constexpr bool PERM = true, MIDHOOK = false, PREFETCH = false, AFTER_DRAIN = false;
    bf16_t* P; const float* ssq; const float* qkg; float* kmean;
    __device__ __forceinline__ void operator()(const f32x4 (&acc)[2][2][4][2], const Unit& u, int wr, int wc, int fr, int fq) const {
        const int hh = 4 * u.pn + wc;
        int type, gi = 0;
        if (hh < 8) { type = 0; gi = 0; } else if (hh < 16) { type = 1; gi = 1; } else if (hh < 24) type = 2; else if (hh < 32) type = 3;
        else if (hh < 56) { type = 0; gi = 2; } else if (hh < 80) { type = 1; gi = 3; } else if (hh < 104) type = 2; else if (hh < 112) type = 3;
        else if (hh < 120) { type = 0; gi = 4; } else if (hh < 122) { type = 1; gi = 5; } else if (hh < 124) type = 2; else if (hh < 132) type = 3; else type = 4;
        const bool is_ka = (hh >= 8 && hh < 16);
        const int dsh = (hh >= 32 && hh < 104) ? 2 * (((hh - 32) % 24) >> 3) : 0;
        f32x4 gn[2][2];
#pragma unroll
        for (int bj = 0; bj < 2; ++bj)
#pragma unroll
            for (int n = 0; n < 2; ++n) gn[bj][n] = (type <= 1) ? *(const f32x4*)(qkg + gi * 64 + 32 * bj + 8 * fq + 4 * n) : (f32x4){1.f, 1.f, 1.f, 1.f};
        f32x4 cs[2][2];
#pragma unroll
        for (int bj = 0; bj < 2; ++bj)
#pragma unroll
            for (int n = 0; n < 2; ++n) cs[bj][n] = (f32x4){0.f, 0.f, 0.f, 0.f};
        float rsv[2][4];
        { f32x4 p4[2][4];
#pragma unroll
          for (int ai = 0; ai < 2; ++ai)
#pragma unroll
            for (int m = 0; m < 4; ++m) p4[ai][m] = *(const f32x4*)(ssq + (size_t)(u.pm * BM + ai * HALF + wr * 64 + m * 16 + fr) * 4);
#pragma unroll
          for (int ai = 0; ai < 2; ++ai)
#pragma unroll
            for (int m = 0; m < 4; ++m) rsv[ai][m] = 1.0f / sqrtf(((p4[ai][m][0] + p4[ai][m][1]) + (p4[ai][m][2] + p4[ai][m][3])) * (1.0f / DM) + EPS); }
#pragma unroll
        for (int ai = 0; ai < 2; ++ai)
#pragma unroll
            for (int m = 0; m < 4; ++m) {
                const int row = u.pm * BM + ai * HALF + wr * 64 + m * 16 + fr;
                const float rs = rsv[ai][m];
                f32x4 v[2][2];
#pragma unroll
                for (int bj = 0; bj < 2; ++bj)
#pragma unroll
                    for (int n = 0; n < 2; ++n) v[bj][n] = acc[ai][bj][m][n] * rs;
                if (type <= 1) {
                    float q = 0.f;
#pragma unroll
                    for (int bj = 0; bj < 2; ++bj)
#pragma unroll
                        for (int n = 0; n < 2; ++n) { const f32x4 x = v[bj][n]; q += (x[0] * x[0] + x[1] * x[1]) + (x[2] * x[2] + x[3] * x[3]); }
                    q = xrow16_sum(q);
                    float rn = 1.0f / sqrtf(q * (1.0f / HD) + EPS); if (type == 0) rn *= C2;
#pragma unroll
                    for (int bj = 0; bj < 2; ++bj)
#pragma unroll
                        for (int n = 0; n < 2; ++n) { v[bj][n] = v[bj][n] * rn * gn[bj][n]; cs[bj][n] += v[bj][n]; }
                } else if (type == 3) {
#pragma unroll
                    for (int bj = 0; bj < 2; ++bj)
#pragma unroll
                        for (int n = 0; n < 2; ++n)
#pragma unroll
                            for (int e = 0; e < 4; ++e) v[bj][n][e] = v[bj][n][e] * fast_sigmoid(v[bj][n][e]);
                } else if (type == 4) {
#pragma unroll
                    for (int bj = 0; bj < 2; ++bj)
#pragma unroll
                        for (int n = 0; n < 2; ++n)
#pragma unroll
                            for (int e = 0; e < 4; ++e) v[bj][n][e] = fast_sigmoid(v[bj][n][e]);
                }
                bf16_t* rowp;
                if (type == 4) rowp = P + GL_OFF + (size_t)row * 3072 + (hh - NHEADS) * 64 + 8 * fq;
                else { int ridx = row;
                    if (dsh) { const int t = row & (SEQ - 1); ridx = (row & ~(SEQ - 1)) + ((t & ((1 << dsh) - 1)) << (11 - dsh)) + (t >> dsh); }
                    rowp = P + ((size_t)hh * M + ridx) * HD + 8 * fq; }
#pragma unroll
                for (int bj = 0; bj < 2; ++bj) { u32x4 w; w.x = cvt_pk_bf16(v[bj][0][0], v[bj][0][1]); w.y = cvt_pk_bf16(v[bj][0][2], v[bj][0][3]); w.z = cvt_pk_bf16(v[bj][1][0], v[bj][1][1]); w.w = cvt_pk_bf16(v[bj][1][2], v[bj][1][3]);
                    if (STORE) *(u32x4*)(rowp + 32 * bj) = w; else asm volatile("" :: "v"(w), "v"(rowp)); }
            }
        if (is_ka) {
#pragma unroll
            for (int bj = 0; bj < 2; ++bj)
#pragma unroll
                for (int n = 0; n < 2; ++n)
#pragma unroll
                    for (int e = 0; e < 4; ++e) { float c = cs[bj][n][e]; c += __shfl_xor(c, 1); c += __shfl_xor(c, 2); c += __shfl_xor(c, 4); c += __shfl_xor(c, 8); cs[bj][n][e] = c; }
            if (fr == 0) {
                float* kp = kmean + ((size_t)(wr * 64 + u.pm) * 8 + (hh - 8)) * 64 + 8 * fq;
#pragma unroll
                for (int bj = 0; bj < 2; ++bj)
#pragma unroll
                    for (int n = 0; n < 2; ++n) *(f32x4*)(kp + 32 * bj + 4 * n) = cs[bj][n];
            }
        }
    }
};

struct EpiNull {
    static constexpr bool PERM = true, MIDHOOK = false, PREFETCH = false, AFTER_DRAIN = false;
    __device__ __forceinline__ void operator()(const f32x4 (&acc)[2][2][4][2], const Unit& u, int wr, int wc, int fr, int fq) const {
#pragma unroll
        for (int a = 0; a < 2; ++a)
#pragma unroll
            for (int b = 0; b < 2; ++b)
#pragma unroll
                for (int m = 0; m < 4; ++m)
#pragma unroll
                    for (int n = 0; n < 2; ++n) asm volatile("" :: "v"(acc[a][b][m][n]));
    }
};
typedef EpiProjT<true> EpiProj;
struct EpiMerge {
    static constexpr bool PERM = true, MIDHOOK = true, PREFETCH = false, AFTER_DRAIN = false;
    const bf16_t* P; bf16_t* MG;
    __device__ __forceinline__ void prefetch(const Unit& u, int t, int tid, PG8_LAS unsigned char* junk) const {
        if (t > 10) return;
        const int L = (t >> 1) * 512 + tid;
        const bf16_t* p = P + GL_OFF + (size_t)(u.pm * BM + ((L >> 2) & 255)) * 3072 + (L >> 10) * DM + u.pn * BM + (L & 3) * 64;
        __builtin_amdgcn_global_load_lds((const unsigned*)p, (PG8_LAS unsigned*)junk, 4, 0, 0);
    }
    __device__ __forceinline__ void mid(f32x4 (&acc)[2][2][4][2], const Unit& u, int seg, int wr, int wc, int fr, int fq) const {
        asm volatile("" : "+v"(fr), "+v"(fq));
#pragma unroll
        for (int ai = 0; ai < 2; ++ai)
#pragma unroll
            for (int m = 0; m < 4; ++m) {
                const int row = u.pm * BM + ai * HALF + wr * 64 + m * 16 + fr;
                const bf16_t* gp = P + GL_OFF + (size_t)row * 3072 + (seg - 1) * DM + u.pn * BM + wc * 32 + 8 * fq;
#pragma unroll
                for (int bj = 0; bj < 2; ++bj) {
                    const u32x4 ga = *(const u32x4*)(gp + bj * HALF), gb = *(const u32x4*)(gp + DM + bj * HALF);
                    f32x4 r0, r1;
                    r0[0] = bf_lo(ga.x) * __builtin_amdgcn_rcpf(fmaxf(bf_lo(gb.x), 1e-30f)); r0[1] = bf_hi(ga.x) * __builtin_amdgcn_rcpf(fmaxf(bf_hi(gb.x), 1e-30f));
                    r0[2] = bf_lo(ga.y) * __builtin_amdgcn_rcpf(fmaxf(bf_lo(gb.y), 1e-30f)); r0[3] = bf_hi(ga.y) * __builtin_amdgcn_rcpf(fmaxf(bf_hi(gb.y), 1e-30f));
                    r1[0] = bf_lo(ga.z) * __builtin_amdgcn_rcpf(fmaxf(bf_lo(gb.z), 1e-30f)); r1[1] = bf_hi(ga.z) * __builtin_amdgcn_rcpf(fmaxf(bf_hi(gb.z), 1e-30f));
                    r1[2] = bf_lo(ga.w) * __builtin_amdgcn_rcpf(fmaxf(bf_lo(gb.w), 1e-30f)); r1[3] = bf_hi(ga.w) * __builtin_amdgcn_rcpf(fmaxf(bf_hi(gb.w), 1e-30f));
                    acc[ai][bj][m][0] *= r0; acc[ai][bj][m][1] *= r1;
                }
                if (m == 3) asm volatile("" ::: "memory");
            }
    }
    __device__ __forceinline__ void operator()(const f32x4 (&acc)[2][2][4][2], const Unit& u, int wr, int wc, int fr, int fq) const {
#pragma unroll
        for (int ai = 0; ai < 2; ++ai)
#pragma unroll
            for (int m = 0; m < 4; ++m) {
                const int row = u.pm * BM + ai * HALF + wr * 64 + m * 16 + fr;
                const int col = u.pn * BM + wc * 32 + 8 * fq;
                const bf16_t* gp = P + GL_OFF + (size_t)row * 3072 + 2 * DM + col;
#pragma unroll
                for (int bj = 0; bj < 2; ++bj) {
                    const u32x4 g = *(const u32x4*)(gp + bj * HALF);
                    const f32x4 a0 = acc[ai][bj][m][0], a1 = acc[ai][bj][m][1];
                    u32x4 w; w.x = cvt_pk_bf16(a0[0] * bf_lo(g.x), a0[1] * bf_hi(g.x)); w.y = cvt_pk_bf16(a0[2] * bf_lo(g.y), a0[3] * bf_hi(g.y));
                    w.z = cvt_pk_bf16(a1[0] * bf_lo(g.z), a1[1] * bf_hi(g.z)); w.w = cvt_pk_bf16(a1[2] * bf_lo(g.w), a1[3] * bf_hi(g.w));
                    *(u32x4*)(MG + (size_t)row * DM + col + bj * HALF) = w;
                }
                if (m == 3) asm volatile("" ::: "memory");
            }
    }
};

struct EpiRes {
    static constexpr bool PERM = false, MIDHOOK = false, PREFETCH = false, AFTER_DRAIN = true;
    const float* xold; float* xout; bf16_t* XB; float* ssq;
    __device__ __forceinline__ void prefetch(const Unit& u, int t, int tid, PG8_LAS unsigned char* junk) const {
        if (tid >= 256) return;
        const int L = (t >> 1) * 256 + tid;
        const float* p = xold + (size_t)(u.pm * BM + (L >> 3)) * DM + u.pn * BM + (L & 7) * 32;
        __builtin_amdgcn_global_load_lds((const unsigned*)p, (PG8_LAS unsigned*)junk, 4, 0, 0);
    }
    __device__ __forceinline__ void fused(const f32x4 (&acc)[2][2][4][2], const Unit& u, int wr, int wc, int fr, int fq, PG8_LAS unsigned char* lds, int wid, int lane) const {
        PG8_LAS float* part = (PG8_LAS float*)lds;
#pragma unroll
        for (int ai = 0; ai < 2; ++ai)
#pragma unroll
            for (int m = 0; m < 4; ++m) {
                const int r = ai * HALF + wr * 64 + m * 16 + fr;
                const size_t off = (size_t)(u.pm * BM + r) * DM + u.pn * BM + wc * 32 + 4 * fq;
                float ss = 0.f;
#pragma unroll
                for (int bj = 0; bj < 2; ++bj)
#pragma unroll
                    for (int n = 0; n < 2; ++n) {
                        const size_t o = off + bj * HALF + n * 16;
                        const f32x4 x = *(const f32x4*)(xold + o) + acc[ai][bj][m][n];
                        *(f32x4*)(xout + o) = x;
                        u32x2 w; w.x = cvt_pk_bf16(x[0], x[1]); w.y = cvt_pk_bf16(x[2], x[3]); *(u32x2*)(XB + o) = w;
                        ss += (x[0] * x[0] + x[1] * x[1]) + (x[2] * x[2] + x[3] * x[3]);
                    }
                ss = xrow16_sum(ss);
                if (fq == 0) part[r * 4 + wc] = ss;
                if (m & 1) asm volatile("" ::: "memory");
            }
        asm volatile("s_waitcnt lgkmcnt(0)" ::: "memory"); __builtin_amdgcn_s_barrier(); asm volatile("" ::: "memory");
        const int tid = wid * 64 + lane;
        if (tid < 256) { const f32x4 p = *(const PG8_LAS f32x4*)(part + tid * 4); ssq[(size_t)(u.pm * BM + tid) * 4 + u.pn] = (p[0] + p[1]) + (p[2] + p[3]); }
    }
};
}

constexpr int NWAVES = 8;
constexpr int N_PHASES = 1 + 4 * DEPTH;
constexpr size_t MiB = 1u << 20;
constexpr size_t WS_CTL = 0, CTL_ZERO_BYTES = 1 * MiB;
constexpr size_t WS_WIN = 1 * MiB;
constexpr size_t WS_WBR = WS_WIN + (size_t)DEPTH * CIN * DM * 2;
constexpr size_t WS_WOUT = WS_WBR + (size_t)DEPTH * DM * BRP * 2;
constexpr size_t WS_P = WS_WOUT + (size_t)DEPTH * DM * DM * 2;
constexpr size_t WS_BR = WS_P + (size_t)M * CIN * 2;
constexpr size_t WS_MG = WS_BR + (size_t)M * BRP * 2;
constexpr size_t WS_XB = WS_MG + (size_t)M * DM * 2;
constexpr size_t WS_OG = WS_XB + (size_t)M * DM * 2;
constexpr size_t WS_LSE = WS_OG + (size_t)3 * M * WBR * 2;
constexpr size_t WS_SSQ = WS_LSE + (size_t)3 * M * 8 * 4;
constexpr size_t WS_KM = WS_SSQ + (size_t)M * 16 * 4;
constexpr size_t WS_BIAS = WS_KM + (size_t)2 * 64 * 8 * 64 * 4;
constexpr size_t WS_QKG = WS_BIAS + (size_t)NH_TOT * SEQ * 4;
constexpr size_t WS_SINK = WS_QKG + (size_t)DEPTH * 6 * HD * 4;
constexpr size_t WS_PTRS = WS_SINK + 1024;
constexpr size_t WS_END = WS_SINK + 4096;
constexpr int CW_BAR = 4096;

constexpr int RING_OFF = 0, RING_BYTES = 131072;
constexpr int LDSCTL_OFF = RING_BYTES, MISC_OFF = LDSCTL_OFF + 320;
constexpr int LDS_BYTES = 147456;
constexpr int VSTR = 144;
constexpr int AT_VT = 0, AT_VT_WAVE = 32 * VSTR;
constexpr int AT_TAB = 40960;
constexpr int AT_KM = AT_TAB + 2080 * 4;
constexpr int AT_RING = AT_KM + 8 * 64 * 4;
constexpr int AT_KM2 = AT_TAB + 4 * 2128 * 4;
constexpr int AT_RING2 = AT_KM2 + 8 * 64 * 4;
static_assert(AT_VT + NWAVES * AT_VT_WAVE <= AT_TAB && AT_RING2 + 2 * 128 * VSTR <= RING_BYTES && AT_RING2 % 16 == 0 && AT_TAB % 16 == 0, "attention LDS map");

#define GAS __attribute__((address_space(1)))
#define LAS __attribute__((address_space(3)))
typedef unsigned short bf16;
typedef unsigned v4u __attribute__((ext_vector_type(4)));
typedef unsigned v2u __attribute__((ext_vector_type(2)));
typedef float f32x4 __attribute__((ext_vector_type(4)));
typedef float f32x16 __attribute__((ext_vector_type(16)));
typedef short bf16x8 __attribute__((ext_vector_type(8)));
typedef short s16x4 __attribute__((ext_vector_type(4)));
typedef GAS unsigned gu32;
#define RLX_AGENT __ATOMIC_RELAXED, __HIP_MEMORY_SCOPE_AGENT
#define LDS_WAIT() asm volatile("s_waitcnt lgkmcnt(0)" ::: "memory")
#define VM_WAIT() asm volatile("s_waitcnt vmcnt(0)" ::: "memory")
using pg8::cvt_pk_bf16; using pg8::bf_lo; using pg8::bf_hi;

#define XB_TMO      128
#define XB_XCNT(j)  (256  + 64 * (j))
#define XB_XSUB(j)  (1280 + 64 * (j))
#define XB_XGEN(j)  (2304 + 64 * (j))
#define XB_TOP      3328
#define XB_TOPGEN   3392
#define XCD_BAR_WORDS 3456
#define XB_SPIN_CAP (1u << 18)
__device__ __forceinline__ unsigned xb_ld(unsigned* p)              { return __hip_atomic_load(p, __ATOMIC_RELAXED, __HIP_MEMORY_SCOPE_AGENT); }
__device__ __forceinline__ unsigned xb_add(unsigned* p, unsigned v) { return __hip_atomic_fetch_add(p, v, __ATOMIC_RELAXED, __HIP_MEMORY_SCOPE_AGENT); }
__device__ __forceinline__ unsigned xb_xcc_id() { return (unsigned)__builtin_amdgcn_s_getreg((3 << 11) | 20) & 0xFu; }
#define XB_SPIN(cond, bar) do { unsigned _sp = 0; while (cond) { __builtin_amdgcn_s_sleep(1); \
    if ((++_sp & 255u) == 0u) { if (xb_ld(&(bar)[XB_TMO])) break; if (_sp > XB_SPIN_CAP) { atomicAdd(&(bar)[XB_TMO], 1u); break; } } } } while (0)
struct XcdBarrier { unsigned* bar; unsigned x; volatile LAS unsigned* st; };
__device__ __forceinline__ XcdBarrier xcd_barrier_post(unsigned* bar, volatile LAS unsigned* st) {
    XcdBarrier b; b.bar = bar; b.x = xb_xcc_id(); b.st = st;
    if (threadIdx.x == 0) (void)xb_add(&bar[XB_XCNT(b.x)], 1u);
    return b;
}
__device__ __forceinline__ void xcd_barrier_complete(unsigned* bar, unsigned x, unsigned& nloc, unsigned& nx) {
    const unsigned G = gridDim.x * gridDim.y * gridDim.z;
    unsigned sum, cnt, mine, sp = 0u;
    for (;;) {
        sum = 0u; cnt = 0u; mine = 0u;
#pragma unroll
        for (unsigned j = 0; j < 16; ++j) { const unsigned c = xb_ld(&bar[XB_XCNT(j)]); sum += c; cnt += (c > 0u) ? 1u : 0u; mine = (j == x) ? c : mine; }
        if (sum == G) break;
        __builtin_amdgcn_s_sleep(1);
        if ((++sp & 255u) == 0u) { if (xb_ld(&bar[XB_TMO])) break; if (sp > XB_SPIN_CAP) { atomicAdd(&bar[XB_TMO], 1u); break; } }
    }
    nloc = mine > 0u ? mine : 1u; nx = cnt > 0u ? cnt : 1u;
}
__device__ __forceinline__ void xcd_barrier(const XcdBarrier& b) {
    asm volatile("s_waitcnt vmcnt(0)" ::: "memory");
    __syncthreads();
    if (threadIdx.x == 0) {
        unsigned* bar = b.bar;
        __builtin_amdgcn_s_waitcnt(0);
        unsigned nloc = b.st[0], nx = b.st[1];
        if (nloc == 0u) { xcd_barrier_complete(bar, b.x, nloc, nx); b.st[0] = nloc; b.st[1] = nx; }
        const unsigned old = xb_add(&bar[XB_XSUB(b.x)], 1u);
        const unsigned gen = old / nloc;
        if (old + 1u == (gen + 1u) * nloc) {
            __builtin_amdgcn_fence(__ATOMIC_RELEASE, "agent");
            asm volatile("s_waitcnt vmcnt(0)" ::: "memory");
            const unsigned og = xb_add(&bar[XB_TOP], 1u);
            const unsigned tg = og / nx;
            if (og + 1u == (tg + 1u) * nx) xb_add(&bar[XB_TOPGEN], 1u);
            else XB_SPIN(xb_ld(&bar[XB_TOPGEN]) == tg, bar);
            __builtin_amdgcn_fence(__ATOMIC_ACQUIRE, "agent");
            xb_add(&bar[XB_XGEN(b.x)], 1u);
            asm volatile("s_waitcnt vmcnt(0)" ::: "memory");
        } else {
            XB_SPIN(xb_ld(&bar[XB_XGEN(b.x)]) == gen, bar);
            __builtin_amdgcn_fence(__ATOMIC_ACQUIRE, "agent");
            asm volatile("s_waitcnt vmcnt(0)" ::: "memory");
        }
    }
    __syncthreads();
}

struct Frame {
    LAS unsigned char* lds;
    int tid, lane, wave, vcu, G;
    unsigned char* ws; const float* x; float* out;
};
#define F_WINT  ((bf16*)(F.ws + WS_WIN))
#define F_WBRT  ((bf16*)(F.ws + WS_WBR))
#define F_WOUTT ((bf16*)(F.ws + WS_WOUT))
#define F_P     ((bf16*)(F.ws + WS_P))
#define F_BR    ((bf16*)(F.ws + WS_BR))
#define F_MG    ((bf16*)(F.ws + WS_MG))
#define F_XB    ((bf16*)(F.ws + WS_XB))
#define F_OG    ((bf16*)(F.ws + WS_OG))
#define F_LSE   ((float*)(F.ws + WS_LSE))
#define F_SSQ   ((float*)(F.ws + WS_SSQ))
#define F_KM    ((float*)(F.ws + WS_KM))
#define F_BIAS  ((float*)(F.ws + WS_BIAS))
#define F_QKG   ((float*)(F.ws + WS_QKG))
#define F_SINK  ((float*)(F.ws + WS_SINK))

__device__ __forceinline__ void p0_transpose_item(const float* W, int ldw, int k0, int n0, bf16* WT, int ldt, int dst_row0, const float* kscale, LAS float* scr, int lane) {
#pragma unroll
    for (int i = 0; i < 32; ++i) { const int kk = 2 * i + (lane >> 5); float v = W[(size_t)(k0 + kk) * ldw + n0 + (lane & 31)]; if (kscale) v *= kscale[k0 + kk]; scr[kk * 33 + (lane & 31)] = v; }
    LDS_WAIT(); asm volatile("" ::: "memory");
    const int c = lane & 7;
#pragma unroll
    for (int j = 0; j < 4; ++j) { const int n = (lane >> 3) + 8 * j; const LAS float* s = scr + (8 * c) * 33 + n;
        v4u o; o.x = cvt_pk_bf16(s[0 * 33], s[1 * 33]); o.y = cvt_pk_bf16(s[2 * 33], s[3 * 33]); o.z = cvt_pk_bf16(s[4 * 33], s[5 * 33]); o.w = cvt_pk_bf16(s[6 * 33], s[7 * 33]);
        *(GAS v4u*)(WT + (size_t)(dst_row0 + n) * ldt + k0 + 8 * c) = o; }
    LDS_WAIT(); asm volatile("" ::: "memory");
}
__device__ __forceinline__ float wave_sum(float v) {
#pragma unroll
    for (int o = 1; o < 64; o <<= 1) v += __shfl_xor(v, o);
    return v;
}
__device__ __forceinline__ int rel_bucket_dev(int dist) {
    if (dist < 16) return dist;
    int b = 16;
    b += dist >= 22; b += dist >= 30; b += dist >= 40; b += dist >= 54; b += dist >= 73; b += dist >= 99; b += dist >= 134; b += dist >= 182;
    b += dist >= 246; b += dist >= 332; b += dist >= 450; b += dist >= 609; b += dist >= 825; b += dist >= 1117; b += dist >= 1513;
    return b;
}
__device__ __forceinline__ void convert_layer(Frame& F, int l, int part, int nparts, const float* ln_g, const float* w_in, const float* w_branch, const float* w_out) {
    LAS float* scr = (LAS float*)(F.lds + RING_OFF + F.wave * 16384);
    const int gw = part * NWAVES + F.wave, NGW = nparts * NWAVES;
    constexpr int I_IN = (DM / 64) * (CIN / 32);
    constexpr int I_BR = (WBR / 64) * (DM / 32);
    constexpr int I_OUT = (DM / 64) * (DM / 32);
    constexpr int NITEMS = I_IN + 3 * I_BR + I_OUT;
    for (int it = gw; it < NITEMS; it += NGW) {
        int r = it;
        if (r < I_IN) {
            const int kb = r / (CIN / 32), nb = r % (CIN / 32);
            const int n0 = 32 * nb, pn = n0 >> 8, wc = (n0 >> 6) & 3, bj = (n0 >> 5) & 1, slot0 = 256 * pn + 128 * bj + 32 * wc;
            p0_transpose_item(w_in + (size_t)l * DM * CIN, CIN, 64 * kb, n0, F_WINT + (size_t)l * CIN * DM, DM, slot0, ln_g + l * DM, scr, F.lane);
            continue;
        }
        r -= I_IN;
        if (r < 3 * I_BR) {
            const int i = r / I_BR, q = r % I_BR, kb = q / (DM / 32), nb = q % (DM / 32);
            p0_transpose_item(w_branch + (size_t)(l * 3 + i) * WBR * DM, DM, 64 * kb, 32 * nb, F_WBRT + (size_t)l * DM * BRP + i * WBR, BRP, 32 * nb, nullptr, scr, F.lane);
            continue;
        }
        r -= 3 * I_BR;
        { const int kb = r / (DM / 32), nb = r % (DM / 32);
          p0_transpose_item(w_out + (size_t)l * DM * DM, DM, 64 * kb, 32 * nb, F_WOUTT + (size_t)l * DM * DM, DM, 32 * nb, nullptr, scr, F.lane); }
    }
}
__device__ __forceinline__ void p0_prologue(Frame& F0, const float* ln_g, const float* w_in, const float* qk_g, const float* sinks, const float* w_branch, const float* w_out, const float* rel_bias) {
    Frame F = F0; asm volatile("" : "+v"(F.tid), "+v"(F.lane));
    const int gw = F.vcu * NWAVES + F.wave, NGW = F.G * NWAVES;
    convert_layer(F, 0, F.vcu, F.G, ln_g, w_in, w_branch, w_out);
    for (int m = gw; m < M; m += NGW) {
        const GAS f32x4* xr = (const GAS f32x4*)(F.x + (size_t)m * DM) + F.lane;
        GAS v2u* o8 = (GAS v2u*)(F_XB + (size_t)m * DM) + F.lane;
        float s = 0.f;
#pragma unroll
        for (int j = 0; j < 4; ++j) { const f32x4 v = xr[64 * j]; s += (v[0] * v[0] + v[1] * v[1]) + (v[2] * v[2] + v[3] * v[3]); v2u w; w.x = cvt_pk_bf16(v[0], v[1]); w.y = cvt_pk_bf16(v[2], v[3]); o8[64 * j] = w; }
        s = wave_sum(s);
        if (F.lane < 4) F_SSQ[(size_t)m * 4 + F.lane] = (F.lane == 0) ? s : 0.f;
    }
    for (int i = (F.vcu * NWAVES + F.wave) * 64 + F.lane; i < NH_TOT * SEQ; i += NGW * 64) { const int hd = i / SEQ, dist = i % SEQ; F_BIAS[i] = rel_bias[hd * NBUCK + rel_bucket_dev(dist)] * LOG2E; }
    if (F.vcu == 0) { for (int i = F.tid; i < DEPTH * 6 * HD; i += NWAVES * 64) F_QKG[i] = qk_g[i]; if (F.tid < DEPTH * 8) F_SINK[F.tid] = sinks[F.tid];
        if (F.tid == 0) { const float** pp = (const float**)(F.ws + WS_PTRS); pp[0] = ln_g; pp[1] = w_in; pp[2] = w_branch; pp[3] = w_out; } }
}

#define PHEAD(hh) (F_P + (size_t)(hh) * M * HD)
struct ATile {
    f32x16 o0, o1, ls;
    __device__ __forceinline__ void init() {
#pragma unroll
        for (int r = 0; r < 16; ++r) { o0[r] = 0.f; o1[r] = 0.f; ls[r] = 0.f; }
    }
};
__device__ __forceinline__ s16x4 vtr(const LAS unsigned char* p) { return __builtin_bit_cast(s16x4, __builtin_amdgcn_ds_read_tr16_b64_v4i16((LAS s16x4*)p)); }

struct KVregs { bf16x8 kf[4]; v4u vr[4]; };
__device__ __forceinline__ void at_load_kv(KVregs& R, const bf16* Kt, const bf16* Vt, int lane) {
    const bf16* kp = Kt + (lane & 31) * HD + 8 * (lane >> 5);
#pragma unroll
    for (int ks = 0; ks < 4; ++ks) R.kf[ks] = *(const bf16x8*)(kp + 16 * ks);
#pragma unroll
    for (int i = 0; i < 4; ++i) R.vr[i] = *(const v4u*)(Vt + i * 512 + lane * 8);
}
__device__ __forceinline__ void at_stage_v(const v4u (&vr)[4], LAS unsigned char* vt, int lane) {
#pragma unroll
    for (int i = 0; i < 4; ++i) *(LAS v4u*)(vt + ((lane >> 3) + 8 * i) * VSTR + (lane & 7) * 16) = vr[i];
}
template <int NS> __device__ __forceinline__ void at_read_v(bf16x8 (&vf)[NS][2], const LAS unsigned char* vt, int lane) {
    const int hi = lane >> 5, dsub = (lane >> 4) & 1, q4 = (lane & 15) >> 2, p4 = lane & 3;
    const LAS unsigned char* vb = vt + (4 * hi + q4) * VSTR + (16 * dsub + 4 * p4) * 2;
#pragma unroll
    for (int sidx = 0; sidx < NS; ++sidx)
#pragma unroll
        for (int dt = 0; dt < 2; ++dt) {
            const s16x4 lo = vtr(vb + (16 * sidx) * VSTR + dt * 64), hi4 = vtr(vb + (16 * sidx + 8) * VSTR + dt * 64);
            vf[sidx][dt] = (bf16x8){lo[0], lo[1], lo[2], lo[3], hi4[0], hi4[1], hi4[2], hi4[3]};
        }
}
__device__ __forceinline__ f32x16 at_bias(const LAS float* tp) {
    f32x16 s; const LAS f32x4* bp = (const LAS f32x4*)tp;
#pragma unroll
    for (int g = 0; g < 4; ++g) { const f32x4 b = bp[2 * g];
#pragma unroll
        for (int e = 0; e < 4; ++e) s[4 * g + e] = b[e]; }
    return s;
}
template <int NT> __device__ __forceinline__ void at_step(ATile& T, f32x16 (&s)[NT], const LAS unsigned char* vt, int lane) {
    bf16x8 vf[2 * NT][2];
    at_read_v<2 * NT>(vf, vt, lane);
    __builtin_amdgcn_sched_barrier(0);
    v4u pw[2 * NT];
#pragma unroll
    for (int t = 0; t < NT; ++t) {
#pragma unroll
        for (int r = 0; r < 16; ++r) s[t][r] = __builtin_amdgcn_exp2f(s[t][r]);
        pw[2 * t].x = cvt_pk_bf16(s[t][0], s[t][1]); pw[2 * t].y = cvt_pk_bf16(s[t][2], s[t][3]); pw[2 * t].z = cvt_pk_bf16(s[t][4], s[t][5]); pw[2 * t].w = cvt_pk_bf16(s[t][6], s[t][7]);
        pw[2 * t + 1].x = cvt_pk_bf16(s[t][8], s[t][9]); pw[2 * t + 1].y = cvt_pk_bf16(s[t][10], s[t][11]); pw[2 * t + 1].z = cvt_pk_bf16(s[t][12], s[t][13]); pw[2 * t + 1].w = cvt_pk_bf16(s[t][14], s[t][15]);
    }
    __builtin_amdgcn_sched_barrier(0);
    const bf16x8 ones = (bf16x8){0x3F80, 0x3F80, 0x3F80, 0x3F80, 0x3F80, 0x3F80, 0x3F80, 0x3F80};
#pragma unroll
    for (int sidx = 0; sidx < 2 * NT; ++sidx) {
        const bf16x8 pf = __builtin_bit_cast(bf16x8, pw[sidx]);
        T.o0 = __builtin_amdgcn_mfma_f32_32x32x16_bf16(vf[sidx][0], pf, T.o0, 0, 0, 0);
        T.o1 = __builtin_amdgcn_mfma_f32_32x32x16_bf16(vf[sidx][1], pf, T.o1, 0, 0, 0);
        T.ls = __builtin_amdgcn_mfma_f32_32x32x16_bf16(ones, pf, T.ls, 0, 0, 0);
    }
}
__device__ __forceinline__ void at_stage_o(const ATile& T, float scale, LAS unsigned char* vt, int lane) {
    const int qi = lane & 31, hi = lane >> 5;
#pragma unroll
    for (int dt = 0; dt < 2; ++dt)
#pragma unroll
        for (int g4 = 0; g4 < 4; ++g4) {
            const f32x16& o = dt == 0 ? T.o0 : T.o1;
            v2u w; w.x = cvt_pk_bf16(o[4 * g4 + 0] * scale, o[4 * g4 + 1] * scale); w.y = cvt_pk_bf16(o[4 * g4 + 2] * scale, o[4 * g4 + 3] * scale);
            *(LAS v2u*)(vt + qi * VSTR + (32 * dt + 8 * g4 + 4 * hi) * 2) = w;
        }
    asm volatile("" ::: "memory");
}
__device__ __forceinline__ v4u mul_bf16x8(v4u a, v4u g) {
    v4u w;
    w.x = cvt_pk_bf16(bf_lo(a.x) * bf_lo(g.x), bf_hi(a.x) * bf_hi(g.x)); w.y = cvt_pk_bf16(bf_lo(a.y) * bf_lo(g.y), bf_hi(a.y) * bf_hi(g.y));
    w.z = cvt_pk_bf16(bf_lo(a.z) * bf_lo(g.z), bf_hi(a.z) * bf_hi(g.z)); w.w = cvt_pk_bf16(bf_lo(a.w) * bf_lo(g.w), bf_hi(a.w) * bf_hi(g.w));
    return w;
}
__device__ __forceinline__ void at_store_gated(const ATile& T, float scale, const bf16* gate0, bf16* out0, LAS unsigned char* vt, int lane) {
    at_stage_o(T, scale, vt, lane);
#pragma unroll
    for (int i = 0; i < 4; ++i) {
        const int r = 8 * i + (lane >> 3), ch = lane & 7;
        const v4u o = *(const LAS v4u*)(vt + r * VSTR + ch * 16);
        const v4u g = *(const v4u*)(gate0 + (size_t)r * HD + ch * 8);
        *(v4u*)(out0 + (size_t)r * BRP + ch * 8) = mul_bf16x8(o, g);
    }
    asm volatile("" ::: "memory");
}

constexpr int TABN = 2128;
template <int MODE> __device__ __forceinline__ void moba_unit(Frame& F, int b, int h, int qb) {
    LAS float* tab4 = (LAS float*)(F.lds + AT_TAB);
    LAS float* kml = (LAS float*)(F.lds + AT_KM2);
    LAS unsigned char* kring = F.lds + AT_RING2;
    const int lane = F.lane, qi = lane & 31, hi = lane >> 5, tid = F.tid;
    __syncthreads();
    for (int y = tid; y < TABN + 3; y += NWAVES * 64) {
        const int dlt = 2047 - y; const float v = dlt >= 0 ? F_BIAS[(OFF_A + h) * SEQ + dlt] : -INFINITY;
#pragma unroll
        for (int k = 0; k < 4; ++k) { const int i = y - k; if (i >= 0 && i < TABN) tab4[k * TABN + i] = v; }
    }
    for (int i = tid; i < qb * 64; i += NWAVES * 64) { const int kb = i >> 6, d = i & 63, pm = b * 8 + kb;
        kml[i] = F_KM[((size_t)(0 * 64 + pm) * 8 + h) * 64 + d] + F_KM[((size_t)(1 * 64 + pm) * 8 + h) * 64 + d]; }
    const size_t rowb = (size_t)b * SEQ;
    const bf16* Kg = PHEAD(8 + h) + rowb * HD; const bf16* Vg = PHEAD(16 + h) + rowb * HD;
    const int ntile = 4 * (qb + 1);
    v4u rk = *(const v4u*)(Kg + tid * 8), rv = *(const v4u*)(Vg + tid * 8);
    const int soff = (tid >> 3) * VSTR + (tid & 7) * 16;
    __syncthreads();
    const int tq0 = qb * 256 + 32 * F.wave;
    const size_t qrow = rowb + tq0 + qi;
    bf16x8 qf[4];
#pragma unroll
    for (int ks = 0; ks < 4; ++ks) qf[ks] = *(const bf16x8*)(PHEAD(0 + h) + qrow * HD + 16 * ks + 8 * hi);
    unsigned selmask = (1u << qb) - 1u;
    if (qb > 3) {
        float gt[7];
#pragma unroll
        for (int kb = 0; kb < 7; ++kb) {
            float a = 0.f;
            if (kb < qb) {
#pragma unroll
                for (int ks = 0; ks < 4; ++ks)
#pragma unroll
                    for (int j = 0; j < 8; ++j) a += __builtin_bit_cast(float, ((unsigned)(unsigned short)qf[ks][j]) << 16) * kml[kb * 64 + 16 * ks + 8 * hi + j];
                a += __shfl_xor(a, 32);
            }
            gt[kb] = a;
        }
        selmask = 0u;
#pragma unroll
        for (int pick = 0; pick < 3; ++pick) {
            float best = -INFINITY; int bi = 0;
#pragma unroll
            for (int kb = 0; kb < 7; ++kb) { const bool ok = (kb < qb) && !((selmask >> kb) & 1u) && (gt[kb] > best); best = ok ? gt[kb] : best; bi = ok ? kb : bi; }
            selmask |= 1u << bi;
        }
    }
    *(LAS v4u*)(kring + soff) = rk; *(LAS v4u*)(kring + 64 * VSTR + soff) = rv;
    __syncthreads();
    const int kcopy = (3 - qi) & 3;
    const LAS float* tabk = tab4 + kcopy * TABN;
    const int ybase = 2047 - (tq0 + qi) + 4 * hi - kcopy;
    ATile T; T.init();
    for (int t = 0; t < ntile; ++t) {
        LAS unsigned char* slot = kring + (t & 1) * (128 * VSTR);
        if (MODE != 3 && t + 1 < ntile) { rk = *(const v4u*)(Kg + (size_t)(t + 1) * 4096 + tid * 8); rv = *(const v4u*)(Vg + (size_t)(t + 1) * 4096 + tid * 8); }
        const int kb = t >> 2, j = t & 3;
        const bool own = (kb == qb);
        const bool sel = own || ((selmask >> kb) & 1u);
        const bool need = own ? (2 * j <= F.wave) : (__any(sel) != 0);
        if (need && MODE != 2) {
            const int tk0 = kb * 256 + 64 * j;
            f32x16 s[2];
            bf16x8 k0[4], k1[4];
            { const LAS unsigned char* kp = slot + qi * VSTR + 16 * hi;
#pragma unroll
              for (int ks = 0; ks < 4; ++ks) { k0[ks] = *(const LAS bf16x8*)(kp + 32 * ks); k1[ks] = *(const LAS bf16x8*)(kp + 32 * VSTR + 32 * ks); }
              const LAS float* tp = tabk + (sel ? ybase + tk0 : 2048);
              s[0] = at_bias(tp); s[1] = at_bias(tp + 32); }
            __builtin_amdgcn_sched_barrier(0);
#pragma unroll
            for (int ks = 0; ks < 4; ++ks) {
                s[0] = __builtin_amdgcn_mfma_f32_32x32x16_bf16(k0[ks], qf[ks], s[0], 0, 0, 0);
                s[1] = __builtin_amdgcn_mfma_f32_32x32x16_bf16(k1[ks], qf[ks], s[1], 0, 0, 0);
            }
            __builtin_amdgcn_sched_barrier(0);
            at_step<2>(T, s, slot + 64 * VSTR, lane);
        }
        if (t + 1 < ntile) { LAS unsigned char* nslot = kring + ((t + 1) & 1) * (128 * VSTR); *(LAS v4u*)(nslot + soff) = rk; *(LAS v4u*)(nslot + 64 * VSTR + soff) = rv; }
        __syncthreads();
    }
    const float ltot = T.ls[0];
    if (MODE != 0) { asm volatile("" :: "v"(T.o0), "v"(T.o1), "v"(ltot)); return; }
    { const size_t q0 = rowb + tq0; at_store_gated(T, 1.0f / ltot, PHEAD(24 + h) + q0 * HD, F_BR + q0 * BRP + 0 * WBR + h * 64, F.lds + AT_VT + F.wave * AT_VT_WAVE, lane); }
}

constexpr int TABS = 208;
__device__ __forceinline__ void swa_unit(Frame& F, int b, int spn, int hq, const float* sinks_l) {
    LAS float* tab4 = (LAS float*)(F.lds + AT_TAB);
    LAS unsigned char* vt = F.lds + AT_VT + F.wave * AT_VT_WAVE;
    const int lane = F.lane, qi = lane & 31, hi = lane >> 5;
    __syncthreads();
    for (int i = F.tid; i < 4 * TABS; i += NWAVES * 64) { const int k = i / TABS, y = i % TABS + k, dlt = 160 - y; tab4[i] = (dlt >= 0 && dlt < 128) ? F_BIAS[(OFF_C + hq) * SEQ + dlt] : -INFINITY; }
    __syncthreads();
    const int tq0 = spn * 256 + 32 * F.wave, kvh = hq >> 2;
    const size_t rowb = (size_t)b * SEQ, qrow = rowb + tq0 + qi;
    bf16x8 qf[4];
#pragma unroll
    for (int ks = 0; ks < 4; ++ks) qf[ks] = *(const bf16x8*)(PHEAD(112 + hq) + qrow * HD + 16 * ks + 8 * hi);
    const bf16* Kg = PHEAD(120 + kvh) + rowb * HD; const bf16* Vg = PHEAD(122 + kvh) + rowb * HD;
    int kt0 = 4 - (tq0 >> 5); kt0 = kt0 < 0 ? 0 : kt0;
    const int kcopy = (0 - qi) & 3;
    const LAS float* tabk = tab4 + kcopy * TABS + (32 - qi + 4 * hi - kcopy);
    ATile T; T.init();
    KVregs A; { const int tk0 = tq0 - 128 + 32 * kt0; at_load_kv(A, Kg + (size_t)tk0 * HD, Vg + (size_t)tk0 * HD, lane); }
    for (int kt = kt0; kt < 5; ++kt) {
        KVregs Bn; { const int ktn = kt + 1 < 5 ? kt + 1 : 4; const int tkn = tq0 - 128 + 32 * ktn; at_load_kv(Bn, Kg + (size_t)tkn * HD, Vg + (size_t)tkn * HD, lane); }
        at_stage_v(A.vr, vt, lane);
        f32x16 s[1]; s[0] = at_bias(tabk + 32 * kt);
        __builtin_amdgcn_sched_barrier(0);
#pragma unroll
        for (int ks = 0; ks < 4; ++ks) s[0] = __builtin_amdgcn_mfma_f32_32x32x16_bf16(A.kf[ks], qf[ks], s[0], 0, 0, 0);
        at_step<1>(T, s, vt, lane);
        A = Bn;
    }
    const float sk = sinks_l[hq] * LOG2E;
    const float ltot = T.ls[0] + __builtin_amdgcn_exp2f(sk);
    { const size_t q0 = rowb + tq0; at_store_gated(T, 1.0f / ltot, PHEAD(124 + hq) + q0 * HD, F_BR + q0 * BRP + 2 * WBR + hq * 64, vt, lane); }
}

constexpr int B_TAB = 36864, B_L = B_TAB + 3 * 4 * 208 * 4, B_O = 49152, B_OSTR = 144;
static_assert(B_L + 512 * 4 <= B_O && B_O + 512 * B_OSTR <= RING_BYTES, "dilated LDS map");
template <int MODE> __device__ __forceinline__ void dil_unit(Frame& F, int b, int h, int sp) {
    LAS float* tab4 = (LAS float*)(F.lds + B_TAB);
    LAS float* lacc = (LAS float*)(F.lds + B_L);
    LAS unsigned char* oacc = F.lds + B_O;
    LAS unsigned char* vt = F.lds + AT_VT + F.wave * AT_VT_WAVE;
    const int lane = F.lane, qi = lane & 31, hi = lane >> 5;
    const size_t rowb = (size_t)b * SEQ;
    __syncthreads();
    for (int i = F.tid; i < 3 * 4 * TABS; i += NWAVES * 64) { const int g = i / (4 * TABS), k = (i / TABS) & 3, y = i % TABS + k, dlt = 160 - y, dil = 1 << (2 * g);
        tab4[i] = (dlt >= 0 && dlt <= 128) ? F_BIAS[(OFF_B + g * 8 + h) * SEQ + (dil * dlt > 2047 ? 2047 : dil * dlt)] : -INFINITY; }
    __syncthreads();
    const int kcopy = (0 - qi) & 3;
    for (int g = 0; g < 3; ++g) {
        const int dsh = 2 * g, dil = 1 << dsh;
        for (int t2 = 0; t2 < 2; ++t2) {
            const int tt = 2 * F.wave + t2;
            int res, pq0, nkt, pkb;
            if (g == 0)      { res = 0;       pq0 = 512 * sp + 32 * tt;       nkt = 5;      pkb = pq0 - 128; }
            else if (g == 1) { res = tt >> 2; pq0 = 128 * sp + 32 * (tt & 3); nkt = 5;      pkb = pq0 - 128; }
            else             { res = tt;      pq0 = 32 * sp;                  nkt = sp + 1; pkb = 0; }
            int kt0 = (pkb < 0) ? ((-pkb) >> 5) : 0;
            const int pq = pq0 + qi;
            const size_t rbase = rowb + (size_t)res * (SEQ >> dsh);
            bf16x8 qf[4];
#pragma unroll
            for (int ks = 0; ks < 4; ++ks) qf[ks] = *(const bf16x8*)(PHEAD(32 + g * 8 + h) + (rbase + pq) * HD + 16 * ks + 8 * hi);
            const bf16* Kg = PHEAD(56 + g * 8 + h) + rbase * HD; const bf16* Vg = PHEAD(80 + g * 8 + h) + rbase * HD;
            const LAS float* tabk = tab4 + (g * 4 + kcopy) * TABS + (160 - (pq0 - pkb) - qi + 4 * hi - kcopy);
            ATile T; T.init();
            KVregs A, B1;
            { const int pk0 = pkb + 32 * kt0; at_load_kv(A, Kg + (size_t)pk0 * HD, Vg + (size_t)pk0 * HD, lane);
              const int kt1 = kt0 + 1 < nkt ? kt0 + 1 : nkt - 1; const int pk1 = pkb + 32 * kt1; at_load_kv(B1, Kg + (size_t)pk1 * HD, Vg + (size_t)pk1 * HD, lane); }
            for (int kt = kt0; kt < nkt; ++kt) {
                KVregs C2; if (MODE != 3) { const int ktn = kt + 2 < nkt ? kt + 2 : nkt - 1; const int pkn = pkb + 32 * ktn; at_load_kv(C2, Kg + (size_t)pkn * HD, Vg + (size_t)pkn * HD, lane); } else C2 = A;
                if (MODE == 2) { asm volatile("" :: "v"(A.kf[0]), "v"(A.kf[1]), "v"(A.kf[2]), "v"(A.kf[3]), "v"(A.vr[0]), "v"(A.vr[1]), "v"(A.vr[2]), "v"(A.vr[3])); A = B1; B1 = C2; continue; }
                at_stage_v(A.vr, vt, lane);
                f32x16 s[1]; s[0] = at_bias(tabk + 32 * kt);
                __builtin_amdgcn_sched_barrier(0);
#pragma unroll
                for (int ks = 0; ks < 4; ++ks) s[0] = __builtin_amdgcn_mfma_f32_32x32x16_bf16(A.kf[ks], qf[ks], s[0], 0, 0, 0);
                at_step<1>(T, s, vt, lane);
                A = B1; B1 = C2;
            }
            const float ltile = T.ls[0];
            if (MODE != 0) { asm volatile("" :: "v"(T.o0), "v"(T.o1), "v"(ltile)); continue; }
            const int trow = dil * pq + res - 512 * sp;
            LAS unsigned char* orow = oacc + trow * B_OSTR + 8 * hi;
            float lsum = ltile, inv = 1.f;
            if (g > 0) lsum += lacc[trow];
            if (g == 2) inv = 1.0f / lsum;
#pragma unroll
            for (int dt = 0; dt < 2; ++dt)
#pragma unroll
                for (int g4 = 0; g4 < 4; ++g4) {
                    const f32x16& o = dt == 0 ? T.o0 : T.o1;
                    float v0 = o[4 * g4 + 0], v1 = o[4 * g4 + 1], v2 = o[4 * g4 + 2], v3 = o[4 * g4 + 3];
                    LAS v2u* p = (LAS v2u*)(orow + 64 * dt + 16 * g4);
                    if (g > 0) { const v2u a = *p; v0 += bf_lo(a.x); v1 += bf_hi(a.x); v2 += bf_lo(a.y); v3 += bf_hi(a.y); }
                    v2u w; w.x = cvt_pk_bf16(v0 * inv, v1 * inv); w.y = cvt_pk_bf16(v2 * inv, v3 * inv);
                    *p = w;
                }
            if (g < 2 && hi == 0) lacc[trow] = lsum;
        }
        __syncthreads();
    }
    if (MODE == 0) {
        const int ch = F.tid & 7;
#pragma unroll 4
        for (int i = 0; i < 8; ++i) {
            const int tl = 64 * i + (F.tid >> 3);
            const size_t row = rowb + 512 * sp + tl;
            const v4u o = *(const LAS v4u*)(oacc + tl * B_OSTR + ch * 16);
            const v4u gg = *(const v4u*)(PHEAD(104 + h) + row * HD + ch * 8);
            *(v4u*)(F_BR + row * BRP + 1 * WBR + h * 64 + ch * 8) = mul_bf16x8(o, gg);
        }
    }
}

__device__ __forceinline__ void attn_phase(Frame& F0, int layer) {
    Frame F = F0; asm volatile("" : "+v"(F.tid), "+v"(F.lane));
    if (DBG_TWICE & 4) for (int u = F.vcu; u < 256; u += F.G) { const int bh = u >> 2, pr = u & 3; moba_unit<DBG_MODE>(F, bh >> 3, bh & 7, pr); moba_unit<DBG_MODE>(F, bh >> 3, bh & 7, 7 - pr); }
    for (int u = F.vcu; u < 256; u += F.G) { const int bh = u >> 2, pr = u & 3; moba_unit<0>(F, bh >> 3, bh & 7, pr); moba_unit<0>(F, bh >> 3, bh & 7, 7 - pr); }
    if (DBG_TWICE & 8) for (int u = F.vcu; u < 256; u += F.G) { const int bh = u >> 2, sp = u & 3; dil_unit<DBG_MODE>(F, bh >> 3, bh & 7, sp); }
    for (int u = F.vcu; u < 256; u += F.G) { const int bh = u >> 2, sp = u & 3; dil_unit<0>(F, bh >> 3, bh & 7, sp); }
    for (int rep = 0; rep < ((DBG_TWICE & 16) ? 2 : 1); ++rep)
    for (int u = F.vcu; u < 512; u += F.G) { const int hq = u & 7, spn = (u >> 3) & 7, b = u >> 6; swa_unit(F, b, spn, hq, F_SINK + layer * 8); }
    __syncthreads();
}

struct Args { const float* in[8]; float* out; unsigned char* ws; int ph_lo, ph_hi; };
__global__ void __launch_bounds__(NWAVES * 64, 2) trunk_fwd(Args args) {
    extern __shared__ __attribute__((aligned(16))) unsigned char lds[];
    Frame F;
    F.lds = (LAS unsigned char*)lds;
    F.tid = threadIdx.x; F.lane = F.tid & 63; F.wave = __builtin_amdgcn_readfirstlane(F.tid >> 6);
    F.G = gridDim.x; { const int bx = blockIdx.x; F.vcu = (F.G % 8 == 0) ? (bx % 8) * (F.G / 8) + bx / 8 : bx; }
    unsigned char* ws = args.ws;
    F.x = args.in[0]; F.ws = ws;
    F.out = args.out;
    for (int u = F.tid; u < (LDS_BYTES - LDSCTL_OFF) / 4; u += NWAVES * 64) ((LAS unsigned*)(F.lds + LDSCTL_OFF))[u] = 0u;
    __syncthreads();
    XcdBarrier bar; bar.bar = (unsigned*)(ws + WS_CTL) + CW_BAR; bar.x = 0; bar.st = nullptr;
    if (!MK_PER_PHASE) bar = xcd_barrier_post((unsigned*)(ws + WS_CTL) + CW_BAR, (volatile LAS unsigned*)(F.lds + MISC_OFF) + 8);
    const int lo = args.ph_lo, hi = args.ph_hi;
#define IN(k) (lo <= (k) && (k) < hi)
#define SEAM(k) do { if (IN(k) && IN((k) + 1)) xcd_barrier(bar); } while (0)
    if (IN(0) && (DBG_PH & 1)) { for (int rep = 0; rep < ((DBG_TWICE & 1) ? 2 : 1); ++rep) p0_prologue(F, args.in[1], args.in[2], args.in[3], args.in[4], args.in[5], args.in[6], args.in[7]); SEAM(0); }
    for (int l = 0; l < DEPTH; ++l) {
        const int p1 = 1 + 4 * l;
        if (IN(p1) && (DBG_PH & 2)) {
            pg8::Gemm g{F_XB, F_WINT + (size_t)l * CIN * DM, M, CIN, DM}; pg8::StaticOrder S; S.init(M, CIN, F.G, (int)blockIdx.x);
            pg8::EpiProj E{F_P, F_SSQ, F_QKG + l * 6 * HD, F_KM};
            if (G1_STAGGER_TICKS > 0) {
                if (F.tid == 0) { const unsigned long long t0 = __builtin_amdgcn_s_memrealtime(), dt = (unsigned long long)(((unsigned)blockIdx.x >> 3) & 3u) * G1_STAGGER_TICKS;
                    while (__builtin_amdgcn_s_memrealtime() - t0 < dt) __builtin_amdgcn_s_sleep(8); }
                __syncthreads();
            }
            if (DBG_TWICE & 128) { pg8::EpiProjT<false> EN{F_P, F_SSQ, F_QKG + l * 6 * HD, F_KM}; pg8::gemm_phase<pg8::EpiProjT<false>, pg8::StaticOrder, true, true>(F.lds + RING_OFF, g, S, EN); }
            if (DBG_TWICE & 64) { pg8::EpiNull EN; pg8::gemm_phase<pg8::EpiNull, pg8::StaticOrder, true, true>(F.lds + RING_OFF, g, S, EN); }
            for (int rep = 0; rep < ((DBG_TWICE & 2) ? 2 : 1); ++rep) pg8::gemm_phase<pg8::EpiProj, pg8::StaticOrder, true, true>(F.lds + RING_OFF, g, S, E);
            if (l + 1 < DEPTH) {
                const int nwg = (M / 256) * (CIN / 256), G = F.G, rounds = (nwg + G - 1) / G, nbusy = nwg - (rounds - 1) * G;
                const int c = (int)blockIdx.x;
                if (nbusy == G || c >= nbusy) {
                    Frame F2 = F; asm volatile("" : "+v"(F2.tid), "+v"(F2.lane));
                    const float* const* pp = (const float* const*)(F.ws + WS_PTRS);
                    __syncthreads();
                    convert_layer(F2, l + 1, nbusy == G ? c : c - nbusy, nbusy == G ? G : G - nbusy, pp[0], pp[1], pp[2], pp[3]);
                }
            }
            SEAM(p1);
        }
        if (IN(p1 + 1) && (DBG_PH & 4)) { attn_phase(F, l); SEAM(p1 + 1); }
        if (IN(p1 + 2) && (DBG_PH & 8)) {
            pg8::Gemm g{F_BR, F_WBRT + (size_t)l * DM * BRP, M, DM, BRP}; pg8::StaticOrder S; S.init(M, DM, F.G, (int)blockIdx.x);
            pg8::EpiMerge E{F_P, F_MG};
            if (DBG_TWICE & 256) { pg8::EpiNull EN; pg8::gemm_phase<pg8::EpiNull, pg8::StaticOrder, true, true>(F.lds + RING_OFF, g, S, EN); }
            for (int rep = 0; rep < ((DBG_TWICE & 32) ? 2 : 1); ++rep) pg8::gemm_phase<pg8::EpiMerge, pg8::StaticOrder, true, true>(F.lds + RING_OFF, g, S, E);
            SEAM(p1 + 2);
        }
        if (IN(p1 + 3) && (DBG_PH & 16)) {
            pg8::Gemm g{F_MG, F_WOUTT + (size_t)l * DM * DM, M, DM, DM}; pg8::StaticOrder S; S.init(M, DM, F.G, (int)blockIdx.x);
            pg8::EpiRes E{l == 0 ? F.x : F.out, F.out, F_XB, F_SSQ};
            pg8::gemm_phase<pg8::EpiRes, pg8::StaticOrder, false, true>(F.lds + RING_OFF, g, S, E);
            if (l + 1 < DEPTH) SEAM(p1 + 3);
        }
    }
#undef IN
#undef SEAM
}

extern "C" void kernel_launch(void* const* d_in, const int* in_sizes, int n_in, void* d_out, int out_size, void* d_ws, size_t ws_size, hipStream_t stream) {
    static int grid = 0;
    if (grid == 0) {
        if (n_in != 8 || in_sizes[0] != M * DM || out_size != M * DM || ws_size < WS_END) { fprintf(stderr, "kernel_launch: unexpected shapes (n_in %d, in0 %d, out %d, ws %zu need %zu); nothing launched\n", n_in, n_in > 0 ? in_sizes[0] : -1, out_size, ws_size, (size_t)WS_END); grid = -1; return; }
        int dev = 0, cus = 0, per_cu = 0;
        if (hipGetDevice(&dev) != hipSuccess || hipDeviceGetAttribute(&cus, hipDeviceAttributeMultiprocessorCount, dev) != hipSuccess) { fprintf(stderr, "kernel_launch: device query failed\n"); grid = -1; return; }
        if (hipFuncSetAttribute((const void*)trunk_fwd, hipFuncAttributeMaxDynamicSharedMemorySize, LDS_BYTES) != hipSuccess) { fprintf(stderr, "kernel_launch: hipFuncSetAttribute failed\n"); grid = -1; return; }
        if (hipOccupancyMaxActiveBlocksPerMultiprocessor(&per_cu, (const void*)trunk_fwd, NWAVES * 64, LDS_BYTES) != hipSuccess || per_cu < 1) fprintf(stderr, "kernel_launch: note: occupancy query reports %d workgroups per CU\n", per_cu);
        (void)hipGetLastError();
        grid = cus;
    }
    if (grid < 0) return;
    if (hipMemsetAsync((char*)d_ws + WS_CTL, 0, CTL_ZERO_BYTES, stream) != hipSuccess) { fprintf(stderr, "kernel_launch: memset failed\n"); return; }
    Args a{};
    for (int i = 0; i < 8; ++i) a.in[i] = (const float*)d_in[i];
    a.out = (float*)d_out; a.ws = (unsigned char*)d_ws;
#if MK_PER_PHASE
    for (int p = 0; p < N_PHASES; ++p) { a.ph_lo = p; a.ph_hi = p + 1; hipLaunchKernelGGL(trunk_fwd, dim3(grid), dim3(NWAVES * 64), LDS_BYTES, stream, a); }
#else
    a.ph_lo = 0; a.ph_hi = N_PHASES;
    hipLaunchKernelGGL(trunk_fwd, dim3(grid), dim3(NWAVES * 64), LDS_BYTES, stream, a);
#endif
    const hipError_t le = hipPeekAtLastError();
    if (le != hipSuccess) fprintf(stderr, "kernel_launch: launch failed: %s\n", hipGetErrorName(le));
}
```

```cpp
#include <hip/hip_runtime.h>
#include <cstdio>
#include <cstdint>

#ifndef DBG_PH
#define DBG_PH 31
#endif
#ifndef DBG_TWICE
#define DBG_TWICE 0
#endif
#ifndef G1_STAGGER_TICKS
#define G1_STAGGER_TICKS 0
#endif
#ifndef DBG_MODE
#define DBG_MODE 0
#endif
#ifndef MK_PER_PHASE
#define MK_PER_PHASE 0
#endif

constexpr int BATCH = 8, SEQ = 2048, DM = 1024, DEPTH = 4, HD = 64, WBR = 512;
constexpr int M = BATCH * SEQ;
constexpr int CIN = 11520;
constexpr int NBUCK = 32, NH_TOT = 40, OFF_A = 0, OFF_B = 8, OFF_C = 32;
constexpr int C_QA = 0, C_KA = 512, C_VA = 1024, C_GA = 1536, C_QB = 2048, C_KB = 3584, C_VB = 5120, C_GB = 6656, C_QC = 7168, C_KC = 7680, C_VC = 7808, C_GC = 7936, C_GL = 8448;
constexpr float LOG2E = 1.4426950408889634f;
constexpr float C2 = 0.125f * LOG2E;
constexpr float EPS = 1e-6f;
constexpr int NHEADS = 132;
constexpr size_t GL_OFF = (size_t)NHEADS * 16384 * 64;
constexpr int BRP = 3 * WBR;

namespace pg8 {
#define PG8_LAS __attribute__((address_space(3)))
typedef unsigned short bf16_t;
typedef short bf16x8 __attribute__((ext_vector_type(8)));
typedef float f32x4 __attribute__((ext_vector_type(4)));
typedef unsigned u32x4 __attribute__((ext_vector_type(4)));
typedef unsigned u32x2 __attribute__((ext_vector_type(2)));
constexpr int BM = 256, BK = 64, HALF = 128, HTB = HALF * BK * 2, STAGE_BYTES = 8 * HTB, NXCD = 8, WGM = 8;

__host__ __device__ __forceinline__ int lds_byte(int r, int c) { const int st = (r >> 4) * 2 + (c >> 5), rr = r & 15, cc = c & 31, ob = rr * 64 + cc * 2; return st * 1024 + (ob ^ (((ob >> 9) & 1) << 5)); }
__host__ __device__ __forceinline__ void stage_rc(int b, int& R, int& C) { const int st = b / 1024, sb = b % 1024, swz = sb ^ (((sb >> 9) & 1) << 5); R = (st >> 1) * 16 + swz / 64; C = (st & 1) * 32 + (swz % 64) / 2; }
__host__ __device__ __forceinline__ int perm32(int rho) { const int n = rho >> 4, i = rho & 15; return 8 * (i >> 2) + 4 * n + (i & 3); }

struct Unit { int pm, pn; };
struct Gemm { const bf16_t* A; const bf16_t* Bt; int M, N, K; };

struct StaticOrder {
    int nM, nN, nwg, G, c;
    __host__ __device__ void init(int M_, int N_, int G_, int c_) { nM = M_ / BM; nN = N_ / BM; nwg = nM * nN; G = G_; c = c_; }
    __host__ __device__ bool next(int i, Unit& u) const {
        const long L = (long)i * G + c; if (L >= nwg) return false;
        int wgid = (int)L; { const int q = nwg / NXCD, r = nwg % NXCD, xcd = wgid % NXCD, off = wgid / NXCD; wgid = (xcd < r ? xcd * (q + 1) : r * (q + 1) + (xcd - r) * q) + off; }
        const int nig = WGM * nN, gid = wgid / nig, fm = gid * WGM, gsz = (nM - fm) < WGM ? (nM - fm) : WGM;
        u.pm = fm + ((wgid % nig) % gsz); u.pn = (wgid % nig) / gsz; return true;
    }
    __device__ __forceinline__ void a_ready(const Unit&) const {}
    __device__ __forceinline__ void done(const Unit&) const {}
};

typedef float f32x2 __attribute__((ext_vector_type(2)));
typedef __bf16 bf16x2_t __attribute__((ext_vector_type(2)));
__device__ __forceinline__ unsigned cvt_pk_bf16(float lo, float hi) { f32x2 v = {lo, hi}; bf16x2_t b = __builtin_convertvector(v, bf16x2_t); return __builtin_bit_cast(unsigned, b); }
__device__ __forceinline__ float bf_lo(unsigned w) { return __builtin_bit_cast(float, w << 16); }
__device__ __forceinline__ float bf_hi(unsigned w) { return __builtin_bit_cast(float, w & 0xffff0000u); }

template <class Epi, class Sched, bool ALIGN_EPI = false, bool SP2 = false>
__device__ __forceinline__ void gemm_phase(PG8_LAS unsigned char* lds, const Gemm g, const Sched& S, const Epi& E) {
    int tid_ = threadIdx.x; asm volatile("" : "+v"(tid_));
    const int tid = tid_, wid = __builtin_amdgcn_readfirstlane(tid >> 6), lane = tid & 63, wr = wid >> 2, wc = wid & 3, fr = lane & 15, fq = lane >> 4;
    const int K = g.K, nt = K / BK;
    unsigned voffA[2], voffB[2];
#pragma unroll
    for (int i = 0; i < 2; ++i) { int R, C; stage_rc(tid * 16 + i * 8192, R, C); const int Rb = Epi::PERM ? ((R & ~31) + perm32(R & 31)) : R;
        voffA[i] = (unsigned)(R * K + C) * 2u; voffB[i] = (unsigned)(Rb * K + C) * 2u; }
    const size_t kstep = (size_t)(BK * 2);
    const size_t hstep = (size_t)HALF * K * 2;
    const size_t tstep = 2 * hstep;
    const unsigned ldsw = (unsigned)wid * 1024u;
    const int aoff = lds_byte(wr * 64 + fr, fq * 8), boff = lds_byte(wc * 32 + fr, fq * 8);
#define PG8_SA(b, h) (((b) * 2 + (h)) * HTB)
#define PG8_SB(b, h) ((4 + (b) * 2 + (h)) * HTB)
#define PG8_STAGE(bufoff, gbase, voff) do { _Pragma("unroll") for (int _i = 0; _i < 2; ++_i) \
        __builtin_amdgcn_global_load_lds((const unsigned*)((const char*)(gbase) + (voff)[_i]), (PG8_LAS unsigned*)(lds + (bufoff) + ldsw + _i * 8192), 16, 0, 0); } while (0)
#define PG8_LDA(dst, b, h) do { _Pragma("unroll") for (int m = 0; m < 4; ++m) _Pragma("unroll") for (int k = 0; k < 2; ++k) dst[m][k] = *(const PG8_LAS bf16x8*)(lds + PG8_SA(b, h) + aoff + m * 2048 + k * 1024); } while (0)
#define PG8_LDB(dst, b, h) do { _Pragma("unroll") for (int n = 0; n < 2; ++n) _Pragma("unroll") for (int k = 0; k < 2; ++k) dst[n][k] = *(const PG8_LAS bf16x8*)(lds + PG8_SB(b, h) + boff + n * 2048 + k * 1024); } while (0)
#define PG8_MMA(ai, bj, At, Bt) do { __builtin_amdgcn_s_setprio(1); _Pragma("unroll") for (int m = 0; m < 4; ++m) _Pragma("unroll") for (int n = 0; n < 2; ++n) _Pragma("unroll") for (int k = 0; k < 2; ++k) \
        acc[ai][bj][m][n] = __builtin_amdgcn_mfma_f32_16x16x32_bf16(Bt[n][k], At[m][k], acc[ai][bj][m][n], 0, 0, 0); __builtin_amdgcn_s_setprio(0); } while (0)
#define PG8_WAIT_V(n) asm volatile("s_waitcnt vmcnt(" #n ")" ::: "memory")
#define PG8_WAIT_L(n) asm volatile("s_waitcnt lgkmcnt(" #n ")" ::: "memory")
#define PG8_BAR __builtin_amdgcn_s_barrier()
#define PG8_SCHED __builtin_amdgcn_sched_barrier(0)
    Unit cur, nxt; int ui = 0;
    if (!S.next(0, cur)) return;
    f32x4 acc[2][2][4][2];
#pragma unroll
    for (int a = 0; a < 2; ++a)
#pragma unroll
        for (int b = 0; b < 2; ++b)
#pragma unroll
            for (int m = 0; m < 4; ++m)
#pragma unroll
                for (int n = 0; n < 2; ++n) acc[a][b][m][n] = (f32x4){0.f, 0.f, 0.f, 0.f};
    bf16x8 At[4][2], B0[2][2], B1[2][2];
    const char* cA = (const char*)g.A + (size_t)cur.pm * tstep; const char* cB = (const char*)g.Bt + (size_t)cur.pn * tstep;
    S.a_ready(cur);
    if constexpr (SP2) {
        PG8_STAGE(PG8_SB(0, 0), cB, voffB); PG8_STAGE(PG8_SB(0, 1), cB + hstep, voffB); PG8_STAGE(PG8_SA(0, 0), cA, voffA); PG8_STAGE(PG8_SA(0, 1), cA + hstep, voffA);
        if (wr == 1) PG8_BAR;
        PG8_WAIT_V(2); PG8_BAR;
        PG8_STAGE(PG8_SB(1, 0), cB + kstep, voffB); PG8_STAGE(PG8_SA(1, 0), cA + kstep, voffA); PG8_STAGE(PG8_SB(1, 1), cB + hstep + kstep, voffB);
        PG8_WAIT_V(6); PG8_BAR;
    } else {
        PG8_STAGE(PG8_SB(0, 0), cB, voffB); PG8_STAGE(PG8_SA(0, 0), cA, voffA); PG8_STAGE(PG8_SB(0, 1), cB + hstep, voffB); PG8_STAGE(PG8_SA(0, 1), cA + hstep, voffA);
        if (wr == 1) PG8_BAR;
        PG8_WAIT_V(4); PG8_BAR;
        PG8_STAGE(PG8_SB(1, 0), cB + kstep, voffB); PG8_STAGE(PG8_SA(1, 0), cA + kstep, voffA); PG8_STAGE(PG8_SB(1, 1), cB + hstep + kstep, voffB);
        PG8_WAIT_V(6); PG8_BAR;
    }
    for (;;) {
        const bool has_next = S.next(ui + 1, nxt);
        const char* nA = has_next ? (const char*)g.A + (size_t)nxt.pm * tstep : cA; const char* nB = has_next ? (const char*)g.Bt + (size_t)nxt.pn * tstep : cB;
        for (int t = 0; t < nt; t += 2) {
            const bool last = (t == nt - 2);
            const char* a1 = cA + (size_t)(t + 1) * kstep;
            const char* a2 = last ? nA : cA + (size_t)(t + 2) * kstep; const char* b2 = last ? nB : cB + (size_t)(t + 2) * kstep;
            const char* a3 = a2 + kstep; const char* b3 = b2 + kstep;
            if (last && has_next) S.a_ready(nxt);
            if constexpr (Epi::PREFETCH) E.prefetch(cur, t, tid, lds + STAGE_BYTES + 1024 + wid * 256);
            if constexpr (Epi::MIDHOOK) { if (t == 8 || t == 16) E.mid(acc, cur, t >> 3, wr, wc, fr, fq); }
            if constexpr (SP2) {
            PG8_LDB(B0, 0, 0); PG8_LDB(B1, 0, 1); PG8_SCHED; PG8_LDA(At, 0, 0); PG8_STAGE(PG8_SA(1, 1), a1 + hstep, voffA);
            PG8_WAIT_V(8); PG8_WAIT_L(0); PG8_BAR; PG8_MMA(0, 0, At, B0); PG8_MMA(0, 1, At, B1); PG8_BAR; PG8_SCHED;
            PG8_LDA(At, 0, 1); PG8_STAGE(PG8_SB(0, 0), b2, voffB); PG8_STAGE(PG8_SB(0, 1), b2 + hstep, voffB); PG8_STAGE(PG8_SA(0, 0), a2, voffA);
            PG8_WAIT_V(8); PG8_WAIT_L(0); PG8_BAR; PG8_MMA(1, 0, At, B0); PG8_MMA(1, 1, At, B1); PG8_BAR; PG8_SCHED;
            PG8_LDB(B0, 1, 0); PG8_LDB(B1, 1, 1); PG8_SCHED; PG8_LDA(At, 1, 0); PG8_STAGE(PG8_SA(0, 1), a2 + hstep, voffA);
            PG8_WAIT_V(8); PG8_WAIT_L(0); PG8_BAR; PG8_MMA(0, 0, At, B0); PG8_MMA(0, 1, At, B1); PG8_BAR; PG8_SCHED;
            PG8_LDA(At, 1, 1); PG8_STAGE(PG8_SB(1, 0), b3, voffB); PG8_STAGE(PG8_SB(1, 1), b3 + hstep, voffB); PG8_STAGE(PG8_SA(1, 0), a3, voffA);
            PG8_WAIT_V(8); PG8_WAIT_L(0); PG8_BAR; PG8_MMA(1, 0, At, B0); PG8_MMA(1, 1, At, B1); PG8_BAR; PG8_SCHED;
            } else {
            PG8_LDB(B0, 0, 0); PG8_SCHED; PG8_LDA(At, 0, 0); PG8_STAGE(PG8_SA(1, 1), a1 + hstep, voffA);
            PG8_WAIT_L(8); PG8_BAR; PG8_WAIT_L(0); PG8_MMA(0, 0, At, B0); PG8_BAR; PG8_SCHED;
            PG8_LDB(B1, 0, 1); PG8_STAGE(PG8_SB(0, 0), b2, voffB);
            PG8_BAR; PG8_WAIT_L(0); PG8_MMA(0, 1, At, B1); PG8_BAR;
            PG8_LDA(At, 0, 1); PG8_STAGE(PG8_SA(0, 0), a2, voffA);
            PG8_BAR; PG8_WAIT_L(0); PG8_MMA(1, 0, At, B0); PG8_BAR; PG8_SCHED;
            PG8_STAGE(PG8_SB(0, 1), b2 + hstep, voffB);
            PG8_WAIT_V(6); PG8_BAR; PG8_MMA(1, 1, At, B1); PG8_BAR;
            PG8_LDB(B0, 1, 0); PG8_SCHED; PG8_LDA(At, 1, 0); PG8_STAGE(PG8_SA(0, 1), a2 + hstep, voffA);
            PG8_WAIT_L(8); PG8_BAR; PG8_WAIT_L(0); PG8_MMA(0, 0, At, B0); PG8_BAR; PG8_SCHED;
            PG8_LDB(B1, 1, 1); PG8_STAGE(PG8_SB(1, 0), b3, voffB);
            PG8_BAR; PG8_WAIT_L(0); PG8_MMA(0, 1, At, B1); PG8_BAR;
            PG8_LDA(At, 1, 1); PG8_STAGE(PG8_SA(1, 0), a3, voffA);
            PG8_BAR; PG8_WAIT_L(0); PG8_MMA(1, 0, At, B0); PG8_BAR; PG8_SCHED;
            PG8_STAGE(PG8_SB(1, 1), b3 + hstep, voffB);
            PG8_WAIT_V(6); PG8_BAR; PG8_MMA(1, 1, At, B1); PG8_BAR;
            }
        }
        if constexpr (ALIGN_EPI) { if (wr == 0) PG8_BAR; }
        if constexpr (!Epi::AFTER_DRAIN) { E(acc, cur, wr, wc, fr, fq); S.done(cur); }
        if (!has_next) break;
#pragma unroll
        for (int a = 0; a < 2; ++a)
#pragma unroll
            for (int b = 0; b < 2; ++b)
#pragma unroll
                for (int m = 0; m < 4; ++m)
#pragma unroll
                    for (int n = 0; n < 2; ++n) acc[a][b][m][n] = (f32x4){0.f, 0.f, 0.f, 0.f};
        cur = nxt; cA = nA; cB = nB; ++ui;
        if constexpr (ALIGN_EPI) { if (wr == 1) PG8_BAR; }
    }
    PG8_WAIT_V(0);
    if constexpr (!ALIGN_EPI) { if (wr == 0) PG8_BAR; }
    PG8_BAR;
    if constexpr (Epi::AFTER_DRAIN) { E.fused(acc, cur, wr, wc, fr, fq, lds, wid, lane); S.done(cur); }
#undef PG8_SA
#undef PG8_SB
#undef PG8_STAGE
#undef PG8_LDA
#undef PG8_LDB
#undef PG8_MMA
#undef PG8_WAIT_V
#undef PG8_WAIT_L
#undef PG8_BAR
#undef PG8_SCHED
}

__device__ __forceinline__ void swap16(float x, float& a, float& b) { a = x; b = x; asm volatile("v_nop\n\tv_nop\n\tv_permlane16_swap_b32 %0, %1" : "+v"(a), "+v"(b)); }
__device__ __forceinline__ void swap32(float x, float& a, float& b) { a = x; b = x; asm volatile("v_nop\n\tv_nop\n\tv_permlane32_swap_b32 %0, %1" : "+v"(a), "+v"(b)); }
__device__ __forceinline__ float xrow16_sum(float x) {
    float a, b; swap16(x, a, b); x = a + b; swap32(x, a, b); return a + b;
}
__device__ __forceinline__ float xhalf_max(float x) { float a, b; swap32(x, a, b); return fmaxf(a, b); }
__device__ __forceinline__ float fast_sigmoid(float v) { return __builtin_amdgcn_rcpf(1.0f + __builtin_amdgcn_exp2f(-v * LOG2E)); }

template <bool STORE = true> struct EpiProjT {
    static constexpr bool PERM = true, MIDHOOK = false, PREFETCH = false, AFTER_DRAIN = false;
    bf16_t* P; const float* ssq; const float* qkg; float* kmean;
    __device__ __forceinline__ void operator()(const f32x4 (&acc)[2][2][4][2], const Unit& u, int wr, int wc, int fr, int fq) const {
        const int hh = 4 * u.pn + wc;
        int type, gi = 0;
        if (hh < 8) { type = 0; gi = 0; } else if (hh < 16) { type = 1; gi = 1; } else if (hh < 24) type = 2; else if (hh < 32) type = 3;
        else if (hh < 56) { type = 0; gi = 2; } else if (hh < 80) { type = 1; gi = 3; } else if (hh < 104) type = 2; else if (hh < 112) type = 3;
        else if (hh < 120) { type = 0; gi = 4; } else if (hh < 122) { type = 1; gi = 5; } else if (hh < 124) type = 2; else if (hh < 132) type = 3; else type = 4;
        const bool is_ka = (hh >= 8 && hh < 16);
        const int dsh = (hh >= 32 && hh < 104) ? 2 * (((hh - 32) % 24) >> 3) : 0;
        f32x4 gn[2][2];
#pragma unroll
        for (int bj = 0; bj < 2; ++bj)
#pragma unroll
            for (int n = 0; n < 2; ++n) gn[bj][n] = (type <= 1) ? *(const f32x4*)(qkg + gi * 64 + 32 * bj + 8 * fq + 4 * n) : (f32x4){1.f, 1.f, 1.f, 1.f};
        f32x4 cs[2][2];
#pragma unroll
        for (int bj = 0; bj < 2; ++bj)
#pragma unroll
            for (int n = 0; n < 2; ++n) cs[bj][n] = (f32x4){0.f, 0.f, 0.f, 0.f};
        float rsv[2][4];
        { f32x4 p4[2][4];
#pragma unroll
          for (int ai = 0; ai < 2; ++ai)
#pragma unroll
            for (int m = 0; m < 4; ++m) p4[ai][m] = *(const f32x4*)(ssq + (size_t)(u.pm * BM + ai * HALF + wr * 64 + m * 16 + fr) * 4);
#pragma unroll
          for (int ai = 0; ai < 2; ++ai)
#pragma unroll
            for (int m = 0; m < 4; ++m) rsv[ai][m] = 1.0f / sqrtf(((p4[ai][m][0] + p4[ai][m][1]) + (p4[ai][m][2] + p4[ai][m][3])) * (1.0f / DM) + EPS); }
#pragma unroll
        for (int ai = 0; ai < 2; ++ai)
#pragma unroll
            for (int m = 0; m < 4; ++m) {
                const int row = u.pm * BM + ai * HALF + wr * 64 + m * 16 + fr;
                const float rs = rsv[ai][m];
                f32x4 v[2][2];
#pragma unroll
                for (int bj = 0; bj < 2; ++bj)
#pragma unroll
                    for (int n = 0; n < 2; ++n) v[bj][n] = acc[ai][bj][m][n] * rs;
                if (type <= 1) {
                    float q = 0.f;
#pragma unroll
                    for (int bj = 0; bj < 2; ++bj)
#pragma unroll
                        for (int n = 0; n < 2; ++n) { const f32x4 x = v[bj][n]; q += (x[0] * x[0] + x[1] * x[1]) + (x[2] * x[2] + x[3] * x[3]); }
                    q = xrow16_sum(q);
                    float rn = 1.0f / sqrtf(q * (1.0f / HD) + EPS); if (type == 0) rn *= C2;
#pragma unroll
                    for (int bj = 0; bj < 2; ++bj)
#pragma unroll
                        for (int n = 0; n < 2; ++n) { v[bj][n] = v[bj][n] * rn * gn[bj][n]; cs[bj][n] += v[bj][n]; }
                } else if (type == 3) {
#pragma unroll
                    for (int bj = 0; bj < 2; ++bj)
#pragma unroll
                        for (int n = 0; n < 2; ++n)
#pragma unroll
                            for (int e = 0; e < 4; ++e) v[bj][n][e] = v[bj][n][e] * fast_sigmoid(v[bj][n][e]);
                } else if (type == 4) {
#pragma unroll
                    for (int bj = 0; bj < 2; ++bj)
#pragma unroll
                        for (int n = 0; n < 2; ++n)
#pragma unroll
                            for (int e = 0; e < 4; ++e) v[bj][n][e] = fast_sigmoid(v[bj][n][e]);
                }
                bf16_t* rowp;
                if (type == 4) rowp = P + GL_OFF + (size_t)row * 3072 + (hh - NHEADS) * 64 + 8 * fq;
                else { int ridx = row;
                    if (dsh) { const int t = row & (SEQ - 1); ridx = (row & ~(SEQ - 1)) + ((t & ((1 << dsh) - 1)) << (11 - dsh)) + (t >> dsh); }
                    rowp = P + ((size_t)hh * M + ridx) * HD + 8 * fq; }
#pragma unroll
                for (int bj = 0; bj < 2; ++bj) { u32x4 w; w.x = cvt_pk_bf16(v[bj][0][0], v[bj][0][1]); w.y = cvt_pk_bf16(v[bj][0][2], v[bj][0][3]); w.z = cvt_pk_bf16(v[bj][1][0], v[bj][1][1]); w.w = cvt_pk_bf16(v[bj][1][2], v[bj][1][3]);
                    if (STORE) *(u32x4*)(rowp + 32 * bj) = w; else asm volatile("" :: "v"(w), "v"(rowp)); }
            }
        if (is_ka) {
#pragma unroll
            for (int bj = 0; bj < 2; ++bj)
#pragma unroll
                for (int n = 0; n < 2; ++n)
#pragma unroll
                    for (int e = 0; e < 4; ++e) { float c = cs[bj][n][e]; c += __shfl_xor(c, 1); c += __shfl_xor(c, 2); c += __shfl_xor(c, 4); c += __shfl_xor(c, 8); cs[bj][n][e] = c; }
            if (fr == 0) {
                float* kp = kmean + ((size_t)(wr * 64 + u.pm) * 8 + (hh - 8)) * 64 + 8 * fq;
#pragma unroll
                for (int bj = 0; bj < 2; ++bj)
#pragma unroll
                    for (int n = 0; n < 2; ++n) *(f32x4*)(kp + 32 * bj + 4 * n) = cs[bj][n];
            }
        }
    }
};

struct EpiNull {
    static constexpr bool PERM = true, MIDHOOK = false, PREFETCH = false, AFTER_DRAIN = false;
    __device__ __forceinline__ void operator()(const f32x4 (&acc)[2][2][4][2], const Unit& u, int wr, int wc, int fr, int fq) const {
#pragma unroll
        for (int a = 0; a < 2; ++a)
#pragma unroll
            for (int b = 0; b < 2; ++b)
#pragma unroll
                for (int m = 0; m < 4; ++m)
#pragma unroll
                    for (int n = 0; n < 2; ++n) asm volatile("" :: "v"(acc[a][b][m][n]));
    }
};
typedef EpiProjT<true> EpiProj;
struct EpiMerge {
    static constexpr bool PERM = true, MIDHOOK = true, PREFETCH = false, AFTER_DRAIN = false;
    const bf16_t* P; bf16_t* MG;
    __device__ __forceinline__ void prefetch(const Unit& u, int t, int tid, PG8_LAS unsigned char* junk) const {
        if (t > 10) return;
        const int L = (t >> 1) * 512 + tid;
        const bf16_t* p = P + GL_OFF + (size_t)(u.pm * BM + ((L >> 2) & 255)) * 3072 + (L >> 10) * DM + u.pn * BM + (L & 3) * 64;
        __builtin_amdgcn_global_load_lds((const unsigned*)p, (PG8_LAS unsigned*)junk, 4, 0, 0);
    }
    __device__ __forceinline__ void mid(f32x4 (&acc)[2][2][4][2], const Unit& u, int seg, int wr, int wc, int fr, int fq) const {
        asm volatile("" : "+v"(fr), "+v"(fq));
#pragma unroll
        for (int ai = 0; ai < 2; ++ai)
#pragma unroll
            for (int m = 0; m < 4; ++m) {
                const int row = u.pm * BM + ai * HALF + wr * 64 + m * 16 + fr;
                const bf16_t* gp = P + GL_OFF + (size_t)row * 3072 + (seg - 1) * DM + u.pn * BM + wc * 32 + 8 * fq;
#pragma unroll
                for (int bj = 0; bj < 2; ++bj) {
                    const u32x4 ga = *(const u32x4*)(gp + bj * HALF), gb = *(const u32x4*)(gp + DM + bj * HALF);
                    f32x4 r0, r1;
                    r0[0] = bf_lo(ga.x) * __builtin_amdgcn_rcpf(fmaxf(bf_lo(gb.x), 1e-30f)); r0[1] = bf_hi(ga.x) * __builtin_amdgcn_rcpf(fmaxf(bf_hi(gb.x), 1e-30f));
                    r0[2] = bf_lo(ga.y) * __builtin_amdgcn_rcpf(fmaxf(bf_lo(gb.y), 1e-30f)); r0[3] = bf_hi(ga.y) * __builtin_amdgcn_rcpf(fmaxf(bf_hi(gb.y), 1e-30f));
                    r1[0] = bf_lo(ga.z) * __builtin_amdgcn_rcpf(fmaxf(bf_lo(gb.z), 1e-30f)); r1[1] = bf_hi(ga.z) * __builtin_amdgcn_rcpf(fmaxf(bf_hi(gb.z), 1e-30f));
                    r1[2] = bf_lo(ga.w) * __builtin_amdgcn_rcpf(fmaxf(bf_lo(gb.w), 1e-30f)); r1[3] = bf_hi(ga.w) * __builtin_amdgcn_rcpf(fmaxf(bf_hi(gb.w), 1e-30f));
                    acc[ai][bj][m][0] *= r0; acc[ai][bj][m][1] *= r1;
                }
                if (m == 3) asm volatile("" ::: "memory");
            }
    }
    __device__ __forceinline__ void operator()(const f32x4 (&acc)[2][2][4][2], const Unit& u, int wr, int wc, int fr, int fq) const {
#pragma unroll
        for (int ai = 0; ai < 2; ++ai)
#pragma unroll
            for (int m = 0; m < 4; ++m) {
                const int row = u.pm * BM + ai * HALF + wr * 64 + m * 16 + fr;
                const int col = u.pn * BM + wc * 32 + 8 * fq;
                const bf16_t* gp = P + GL_OFF + (size_t)row * 3072 + 2 * DM + col;
#pragma unroll
                for (int bj = 0; bj < 2; ++bj) {
                    const u32x4 g = *(const u32x4*)(gp + bj * HALF);
                    const f32x4 a0 = acc[ai][bj][m][0], a1 = acc[ai][bj][m][1];
                    u32x4 w; w.x = cvt_pk_bf16(a0[0] * bf_lo(g.x), a0[1] * bf_hi(g.x)); w.y = cvt_pk_bf16(a0[2] * bf_lo(g.y), a0[3] * bf_hi(g.y));
                    w.z = cvt_pk_bf16(a1[0] * bf_lo(g.z), a1[1] * bf_hi(g.z)); w.w = cvt_pk_bf16(a1[2] * bf_lo(g.w), a1[3] * bf_hi(g.w));
                    *(u32x4*)(MG + (size_t)row * DM + col + bj * HALF) = w;
                }
                if (m == 3) asm volatile("" ::: "memory");
            }
    }
};

struct EpiRes {
    static constexpr bool PERM = false, MIDHOOK = false, PREFETCH = false, AFTER_DRAIN = true;
    const float* xold; float* xout; bf16_t* XB; float* ssq;
    __device__ __forceinline__ void prefetch(const Unit& u, int t, int tid, PG8_LAS unsigned char* junk) const {
        if (tid >= 256) return;
        const int L = (t >> 1) * 256 + tid;
        const float* p = xold + (size_t)(u.pm * BM + (L >> 3)) * DM + u.pn * BM + (L & 7) * 32;
        __builtin_amdgcn_global_load_lds((const unsigned*)p, (PG8_LAS unsigned*)junk, 4, 0, 0);
    }
    __device__ __forceinline__ void fused(const f32x4 (&acc)[2][2][4][2], const Unit& u, int wr, int wc, int fr, int fq, PG8_LAS unsigned char* lds, int wid, int lane) const {
        PG8_LAS float* part = (PG8_LAS float*)lds;
#pragma unroll
        for (int ai = 0; ai < 2; ++ai)
#pragma unroll
            for (int m = 0; m < 4; ++m) {
                const int r = ai * HALF + wr * 64 + m * 16 + fr;
                const size_t off = (size_t)(u.pm * BM + r) * DM + u.pn * BM + wc * 32 + 4 * fq;
                float ss = 0.f;
#pragma unroll
                for (int bj = 0; bj < 2; ++bj)
#pragma unroll
                    for (int n = 0; n < 2; ++n) {
                        const size_t o = off + bj * HALF + n * 16;
                        const f32x4 x = *(const f32x4*)(xold + o) + acc[ai][bj][m][n];
                        *(f32x4*)(xout + o) = x;
                        u32x2 w; w.x = cvt_pk_bf16(x[0], x[1]); w.y = cvt_pk_bf16(x[2], x[3]); *(u32x2*)(XB + o) = w;
                        ss += (x[0] * x[0] + x[1] * x[1]) + (x[2] * x[2] + x[3] * x[3]);
                    }
                ss = xrow16_sum(ss);
                if (fq == 0) part[r * 4 + wc] = ss;
                if (m & 1) asm volatile("" ::: "memory");
            }
        asm volatile("s_waitcnt lgkmcnt(0)" ::: "memory"); __builtin_amdgcn_s_barrier(); asm volatile("" ::: "memory");
        const int tid = wid * 64 + lane;
        if (tid < 256) { const f32x4 p = *(const PG8_LAS f32x4*)(part + tid * 4); ssq[(size_t)(u.pm * BM + tid) * 4 + u.pn] = (p[0] + p[1]) + (p[2] + p[3]); }
    }
};
}

constexpr int NWAVES = 8;
constexpr int N_PHASES = 1 + 4 * DEPTH;
constexpr size_t MiB = 1u << 20;
constexpr size_t WS_CTL = 0, CTL_ZERO_BYTES = 1 * MiB;
constexpr size_t WS_WIN = 1 * MiB;
constexpr size_t WS_WBR = WS_WIN + (size_t)DEPTH * CIN * DM * 2;
constexpr size_t WS_WOUT = WS_WBR + (size_t)DEPTH * DM * BRP * 2;
constexpr size_t WS_P = WS_WOUT + (size_t)DEPTH * DM * DM * 2;
constexpr size_t WS_BR = WS_P + (size_t)M * CIN * 2;
constexpr size_t WS_MG = WS_BR + (size_t)M * BRP * 2;
constexpr size_t WS_XB = WS_MG + (size_t)M * DM * 2;
constexpr size_t WS_OG = WS_XB + (size_t)M * DM * 2;
constexpr size_t WS_LSE = WS_OG + (size_t)3 * M * WBR * 2;
constexpr size_t WS_SSQ = WS_LSE + (size_t)3 * M * 8 * 4;
constexpr size_t WS_KM = WS_SSQ + (size_t)M * 16 * 4;
constexpr size_t WS_BIAS = WS_KM + (size_t)2 * 64 * 8 * 64 * 4;
constexpr size_t WS_QKG = WS_BIAS + (size_t)NH_TOT * SEQ * 4;
constexpr size_t WS_SINK = WS_QKG + (size_t)DEPTH * 6 * HD * 4;
constexpr size_t WS_PTRS = WS_SINK + 1024;
constexpr size_t WS_END = WS_SINK + 4096;
constexpr int CW_BAR = 4096;

constexpr int RING_OFF = 0, RING_BYTES = 131072;
constexpr int LDSCTL_OFF = RING_BYTES, MISC_OFF = LDSCTL_OFF + 320;
constexpr int LDS_BYTES = 147456;
constexpr int VSTR = 144;
constexpr int AT_VT = 0, AT_VT_WAVE = 32 * VSTR;
constexpr int AT_TAB = 40960;
constexpr int AT_KM = AT_TAB + 2080 * 4;
constexpr int AT_RING = AT_KM + 8 * 64 * 4;
constexpr int AT_KM2 = AT_TAB + 4 * 2128 * 4;
constexpr int AT_RING2 = AT_KM2 + 8 * 64 * 4;
static_assert(AT_VT + NWAVES * AT_VT_WAVE <= AT_TAB && AT_RING2 + 2 * 128 * VSTR <= RING_BYTES && AT_RING2 % 16 == 0 && AT_TAB % 16 == 0, "attention LDS map");

#define GAS __attribute__((address_space(1)))
#define LAS __attribute__((address_space(3)))
typedef unsigned short bf16;
typedef unsigned v4u __attribute__((ext_vector_type(4)));
typedef unsigned v2u __attribute__((ext_vector_type(2)));
typedef float f32x4 __attribute__((ext_vector_type(4)));
typedef float f32x16 __attribute__((ext_vector_type(16)));
typedef short bf16x8 __attribute__((ext_vector_type(8)));
typedef short s16x4 __attribute__((ext_vector_type(4)));
typedef GAS unsigned gu32;
#define RLX_AGENT __ATOMIC_RELAXED, __HIP_MEMORY_SCOPE_AGENT
#define LDS_WAIT() asm volatile("s_waitcnt lgkmcnt(0)" ::: "memory")
#define VM_WAIT() asm volatile("s_waitcnt vmcnt(0)" ::: "memory")
using pg8::cvt_pk_bf16; using pg8::bf_lo; using pg8::bf_hi;

#define XB_TMO      128
#define XB_XCNT(j)  (256  + 64 * (j))
#define XB_XSUB(j)  (1280 + 64 * (j))
#define XB_XGEN(j)  (2304 + 64 * (j))
#define XB_TOP      3328
#define XB_TOPGEN   3392
#define XCD_BAR_WORDS 3456
#define XB_SPIN_CAP (1u << 18)
__device__ __forceinline__ unsigned xb_ld(unsigned* p)              { return __hip_atomic_load(p, __ATOMIC_RELAXED, __HIP_MEMORY_SCOPE_AGENT); }
__device__ __forceinline__ unsigned xb_add(unsigned* p, unsigned v) { return __hip_atomic_fetch_add(p, v, __ATOMIC_RELAXED, __HIP_MEMORY_SCOPE_AGENT); }
__device__ __forceinline__ unsigned xb_xcc_id() { return (unsigned)__builtin_amdgcn_s_getreg((3 << 11) | 20) & 0xFu; }
#define XB_SPIN(cond, bar) do { unsigned _sp = 0; while (cond) { __builtin_amdgcn_s_sleep(1); \
    if ((++_sp & 255u) == 0u) { if (xb_ld(&(bar)[XB_TMO])) break; if (_sp > XB_SPIN_CAP) { atomicAdd(&(bar)[XB_TMO], 1u); break; } } } } while (0)
struct XcdBarrier { unsigned* bar; unsigned x; volatile LAS unsigned* st; };
__device__ __forceinline__ XcdBarrier xcd_barrier_post(unsigned* bar, volatile LAS unsigned* st) {
    XcdBarrier b; b.bar = bar; b.x = xb_xcc_id(); b.st = st;
    if (threadIdx.x == 0) (void)xb_add(&bar[XB_XCNT(b.x)], 1u);
    return b;
}
__device__ __forceinline__ void xcd_barrier_complete(unsigned* bar, unsigned x, unsigned& nloc, unsigned& nx) {
    const unsigned G = gridDim.x * gridDim.y * gridDim.z;
    unsigned sum, cnt, mine, sp = 0u;
    for (;;) {
        sum = 0u; cnt = 0u; mine = 0u;
#pragma unroll
        for (unsigned j = 0; j < 16; ++j) { const unsigned c = xb_ld(&bar[XB_XCNT(j)]); sum += c; cnt += (c > 0u) ? 1u : 0u; mine = (j == x) ? c : mine; }
        if (sum == G) break;
        __builtin_amdgcn_s_sleep(1);
        if ((++sp & 255u) == 0u) { if (xb_ld(&bar[XB_TMO])) break; if (sp > XB_SPIN_CAP) { atomicAdd(&bar[XB_TMO], 1u); break; } }
    }
    nloc = mine > 0u ? mine : 1u; nx = cnt > 0u ? cnt : 1u;
}
__device__ __forceinline__ void xcd_barrier(const XcdBarrier& b) {
    asm volatile("s_waitcnt vmcnt(0)" ::: "memory");
    __syncthreads();
    if (threadIdx.x == 0) {
        unsigned* bar = b.bar;
        __builtin_amdgcn_s_waitcnt(0);
        unsigned nloc = b.st[0], nx = b.st[1];
        if (nloc == 0u) { xcd_barrier_complete(bar, b.x, nloc, nx); b.st[0] = nloc; b.st[1] = nx; }
        const unsigned old = xb_add(&bar[XB_XSUB(b.x)], 1u);
        const unsigned gen = old / nloc;
        if (old + 1u == (gen + 1u) * nloc) {
            __builtin_amdgcn_fence(__ATOMIC_RELEASE, "agent");
            asm volatile("s_waitcnt vmcnt(0)" ::: "memory");
            const unsigned og = xb_add(&bar[XB_TOP], 1u);
            const unsigned tg = og / nx;
            if (og + 1u == (tg + 1u) * nx) xb_add(&bar[XB_TOPGEN], 1u);
            else XB_SPIN(xb_ld(&bar[XB_TOPGEN]) == tg, bar);
            __builtin_amdgcn_fence(__ATOMIC_ACQUIRE, "agent");
            xb_add(&bar[XB_XGEN(b.x)], 1u);
            asm volatile("s_waitcnt vmcnt(0)" ::: "memory");
        } else {
            XB_SPIN(xb_ld(&bar[XB_XGEN(b.x)]) == gen, bar);
            __builtin_amdgcn_fence(__ATOMIC_ACQUIRE, "agent");
            asm volatile("s_waitcnt vmcnt(0)" ::: "memory");
        }
    }
    __syncthreads();
}

struct Frame {
    LAS unsigned char* lds;
    int tid, lane, wave, vcu, G;
    unsigned char* ws; const float* x; float* out;
};
#define F_WINT  ((bf16*)(F.ws + WS_WIN))
#define F_WBRT  ((bf16*)(F.ws + WS_WBR))
#define F_WOUTT ((bf16*)(F.ws + WS_WOUT))
#define F_P     ((bf16*)(F.ws + WS_P))
#define F_BR    ((bf16*)(F.ws + WS_BR))
#define F_MG    ((bf16*)(F.ws + WS_MG))
#define F_XB    ((bf16*)(F.ws + WS_XB))
#define F_OG    ((bf16*)(F.ws + WS_OG))
#define F_LSE   ((float*)(F.ws + WS_LSE))
#define F_SSQ   ((float*)(F.ws + WS_SSQ))
#define F_KM    ((float*)(F.ws + WS_KM))
#define F_BIAS  ((float*)(F.ws + WS_BIAS))
#define F_QKG   ((float*)(F.ws + WS_QKG))
#define F_SINK  ((float*)(F.ws + WS_SINK))

__device__ __forceinline__ void p0_transpose_item(const float* W, int ldw, int k0, int n0, bf16* WT, int ldt, int dst_row0, const float* kscale, LAS float* scr, int lane) {
#pragma unroll
    for (int i = 0; i < 32; ++i) { const int kk = 2 * i + (lane >> 5); float v = W[(size_t)(k0 + kk) * ldw + n0 + (lane & 31)]; if (kscale) v *= kscale[k0 + kk]; scr[kk * 33 + (lane & 31)] = v; }
    LDS_WAIT(); asm volatile("" ::: "memory");
    const int c = lane & 7;
#pragma unroll
    for (int j = 0; j < 4; ++j) { const int n = (lane >> 3) + 8 * j; const LAS float* s = scr + (8 * c) * 33 + n;
        v4u o; o.x = cvt_pk_bf16(s[0 * 33], s[1 * 33]); o.y = cvt_pk_bf16(s[2 * 33], s[3 * 33]); o.z = cvt_pk_bf16(s[4 * 33], s[5 * 33]); o.w = cvt_pk_bf16(s[6 * 33], s[7 * 33]);
        *(GAS v4u*)(WT + (size_t)(dst_row0 + n) * ldt + k0 + 8 * c) = o; }
    LDS_WAIT(); asm volatile("" ::: "memory");
}
__device__ __forceinline__ float wave_sum(float v) {
#pragma unroll
    for (int o = 1; o < 64; o <<= 1) v += __shfl_xor(v, o);
    return v;
}
__device__ __forceinline__ int rel_bucket_dev(int dist) {
    if (dist < 16) return dist;
    int b = 16;
    b += dist >= 22; b += dist >= 30; b += dist >= 40; b += dist >= 54; b += dist >= 73; b += dist >= 99; b += dist >= 134; b += dist >= 182;
    b += dist >= 246; b += dist >= 332; b += dist >= 450; b += dist >= 609; b += dist >= 825; b += dist >= 1117; b += dist >= 1513;
    return b;
}
template <bool SLOT> __device__ __forceinline__ void convert_item_wg(const float* W, int ldw, int k0, int n0, bf16* WT, int ldt, const float* kscale, LAS float* scr, int tid) {
    const int col = tid & 127, r0 = tid >> 7;
    float v[16];
#pragma unroll
    for (int i = 0; i < 16; ++i) v[i] = W[(size_t)(k0 + r0 + 4 * i) * ldw + n0 + col];
    if (kscale) {
#pragma unroll
        for (int i = 0; i < 16; ++i) v[i] *= kscale[k0 + r0 + 4 * i];
    }
#pragma unroll
    for (int i = 0; i < 16; ++i) scr[(r0 + 4 * i) * 129 + col] = v[i];
    __syncthreads();
    const int ch = tid & 7;
#pragma unroll
    for (int j = 0; j < 2; ++j) {
        const int n = (tid >> 3) + 64 * j; const LAS float* s = scr + (8 * ch) * 129 + n;
        v4u o; o.x = cvt_pk_bf16(s[0 * 129], s[1 * 129]); o.y = cvt_pk_bf16(s[2 * 129], s[3 * 129]); o.z = cvt_pk_bf16(s[4 * 129], s[5 * 129]); o.w = cvt_pk_bf16(s[6 * 129], s[7 * 129]);
        int row = n0 + n;
        if (SLOT) { const int c = n0 + n; row = (c & ~255) + 128 * ((c >> 5) & 1) + 32 * ((c >> 6) & 3) + (c & 31); }
        *(GAS v4u*)(WT + (size_t)row * ldt + k0 + 8 * ch) = o;
    }
    __syncthreads();
}
__device__ __forceinline__ void convert_layer(Frame& F, int l, int part, int nparts, const float* ln_g, const float* w_in, const float* w_branch, const float* w_out) {
    LAS float* scr = (LAS float*)(F.lds + RING_OFF);
    constexpr int I_IN = (DM / 64) * (CIN / 128);
    constexpr int I_BR = (WBR / 64) * (DM / 128);
    constexpr int I_OUT = (DM / 64) * (DM / 128);
    constexpr int NITEMS = I_IN + 3 * I_BR + I_OUT;
    for (int it = part; it < NITEMS; it += nparts) {
        int r = it;
        if (r < I_IN) { const int kb = r / (CIN / 128), nb = r % (CIN / 128);
            convert_item_wg<true>(w_in + (size_t)l * DM * CIN, CIN, 64 * kb, 128 * nb, F_WINT + (size_t)l * CIN * DM, DM, ln_g + l * DM, scr, F.tid); continue; }
        r -= I_IN;
        if (r < 3 * I_BR) { const int i = r / I_BR, q = r % I_BR, kb = q / (DM / 128), nb = q % (DM / 128);
            convert_item_wg<false>(w_branch + (size_t)(l * 3 + i) * WBR * DM, DM, 64 * kb, 128 * nb, F_WBRT + (size_t)l * DM * BRP + i * WBR, BRP, nullptr, scr, F.tid); continue; }
        r -= 3 * I_BR;
        { const int kb = r / (DM / 128), nb = r % (DM / 128);
          convert_item_wg<false>(w_out + (size_t)l * DM * DM, DM, 64 * kb, 128 * nb, F_WOUTT + (size_t)l * DM * DM, DM, nullptr, scr, F.tid); }
    }
}
__device__ __forceinline__ void p0_prologue(Frame& F0, const float* ln_g, const float* w_in, const float* qk_g, const float* sinks, const float* w_branch, const float* w_out, const float* rel_bias) {
    Frame F = F0; asm volatile("" : "+v"(F.tid), "+v"(F.lane));
    const int gw = F.vcu * NWAVES + F.wave, NGW = F.G * NWAVES;
    convert_layer(F, 0, F.vcu, F.G, ln_g, w_in, w_branch, w_out);
    for (int m = gw; m < M; m += NGW) {
        const GAS f32x4* xr = (const GAS f32x4*)(F.x + (size_t)m * DM) + F.lane;
        GAS v2u* o8 = (GAS v2u*)(F_XB + (size_t)m * DM) + F.lane;
        float s = 0.f;
#pragma unroll
        for (int j = 0; j < 4; ++j) { const f32x4 v = xr[64 * j]; s += (v[0] * v[0] + v[1] * v[1]) + (v[2] * v[2] + v[3] * v[3]); v2u w; w.x = cvt_pk_bf16(v[0], v[1]); w.y = cvt_pk_bf16(v[2], v[3]); o8[64 * j] = w; }
        s = wave_sum(s);
        if (F.lane < 4) F_SSQ[(size_t)m * 4 + F.lane] = (F.lane == 0) ? s : 0.f;
    }
    for (int i = (F.vcu * NWAVES + F.wave) * 64 + F.lane; i < NH_TOT * SEQ; i += NGW * 64) { const int hd = i / SEQ, dist = i % SEQ; F_BIAS[i] = rel_bias[hd * NBUCK + rel_bucket_dev(dist)] * LOG2E; }
    if (F.vcu == 0) { for (int i = F.tid; i < DEPTH * 6 * HD; i += NWAVES * 64) F_QKG[i] = qk_g[i]; if (F.tid < DEPTH * 8) F_SINK[F.tid] = sinks[F.tid];
        if (F.tid == 0) { const float** pp = (const float**)(F.ws + WS_PTRS); pp[0] = ln_g; pp[1] = w_in; pp[2] = w_branch; pp[3] = w_out; } }
}

#define PHEAD(hh) (F_P + (size_t)(hh) * M * HD)
struct ATile {
    f32x16 o0, o1, ls;
    __device__ __forceinline__ void init() {
#pragma unroll
        for (int r = 0; r < 16; ++r) { o0[r] = 0.f; o1[r] = 0.f; ls[r] = 0.f; }
    }
};
__device__ __forceinline__ s16x4 vtr(const LAS unsigned char* p) { return __builtin_bit_cast(s16x4, __builtin_amdgcn_ds_read_tr16_b64_v4i16((LAS s16x4*)p)); }

struct KVregs { bf16x8 kf[4]; v4u vr[4]; };
__device__ __forceinline__ void at_load_kv(KVregs& R, const bf16* Kt, const bf16* Vt, int lane) {
    const bf16* kp = Kt + (lane & 31) * HD + 8 * (lane >> 5);
#pragma unroll
    for (int ks = 0; ks < 4; ++ks) R.kf[ks] = *(const bf16x8*)(kp + 16 * ks);
#pragma unroll
    for (int i = 0; i < 4; ++i) R.vr[i] = *(const v4u*)(Vt + i * 512 + lane * 8);
}
__device__ __forceinline__ void at_stage_v(const v4u (&vr)[4], LAS unsigned char* vt, int lane) {
#pragma unroll
    for (int i = 0; i < 4; ++i) *(LAS v4u*)(vt + ((lane >> 3) + 8 * i) * VSTR + (lane & 7) * 16) = vr[i];
}
template <int NS> __device__ __forceinline__ void at_read_v(bf16x8 (&vf)[NS][2], const LAS unsigned char* vt, int lane) {
    const int hi = lane >> 5, dsub = (lane >> 4) & 1, q4 = (lane & 15) >> 2, p4 = lane & 3;
    const LAS unsigned char* vb = vt + (4 * hi + q4) * VSTR + (16 * dsub + 4 * p4) * 2;
#pragma unroll
    for (int sidx = 0; sidx < NS; ++sidx)
#pragma unroll
        for (int dt = 0; dt < 2; ++dt) {
            const s16x4 lo = vtr(vb + (16 * sidx) * VSTR + dt * 64), hi4 = vtr(vb + (16 * sidx + 8) * VSTR + dt * 64);
            vf[sidx][dt] = (bf16x8){lo[0], lo[1], lo[2], lo[3], hi4[0], hi4[1], hi4[2], hi4[3]};
        }
}
__device__ __forceinline__ f32x16 at_bias(const LAS float* tp) {
    f32x16 s; const LAS f32x4* bp = (const LAS f32x4*)tp;
#pragma unroll
    for (int g = 0; g < 4; ++g) { const f32x4 b = bp[2 * g];
#pragma unroll
        for (int e = 0; e < 4; ++e) s[4 * g + e] = b[e]; }
    return s;
}
template <int NT> __device__ __forceinline__ void at_step(ATile& T, f32x16 (&s)[NT], const LAS unsigned char* vt, int lane) {
    bf16x8 vf[2 * NT][2];
    at_read_v<2 * NT>(vf, vt, lane);
    __builtin_amdgcn_sched_barrier(0);
    v4u pw[2 * NT];
#pragma unroll
    for (int t = 0; t < NT; ++t) {
#pragma unroll
        for (int r = 0; r < 16; ++r) s[t][r] = __builtin_amdgcn_exp2f(s[t][r]);
        pw[2 * t].x = cvt_pk_bf16(s[t][0], s[t][1]); pw[2 * t].y = cvt_pk_bf16(s[t][2], s[t][3]); pw[2 * t].z = cvt_pk_bf16(s[t][4], s[t][5]); pw[2 * t].w = cvt_pk_bf16(s[t][6], s[t][7]);
        pw[2 * t + 1].x = cvt_pk_bf16(s[t][8], s[t][9]); pw[2 * t + 1].y = cvt_pk_bf16(s[t][10], s[t][11]); pw[2 * t + 1].z = cvt_pk_bf16(s[t][12], s[t][13]); pw[2 * t + 1].w = cvt_pk_bf16(s[t][14], s[t][15]);
    }
    __builtin_amdgcn_sched_barrier(0);
    const bf16x8 ones = (bf16x8){0x3F80, 0x3F80, 0x3F80, 0x3F80, 0x3F80, 0x3F80, 0x3F80, 0x3F80};
#pragma unroll
    for (int sidx = 0; sidx < 2 * NT; ++sidx) {
        const bf16x8 pf = __builtin_bit_cast(bf16x8, pw[sidx]);
        T.o0 = __builtin_amdgcn_mfma_f32_32x32x16_bf16(vf[sidx][0], pf, T.o0, 0, 0, 0);
        T.o1 = __builtin_amdgcn_mfma_f32_32x32x16_bf16(vf[sidx][1], pf, T.o1, 0, 0, 0);
        T.ls = __builtin_amdgcn_mfma_f32_32x32x16_bf16(ones, pf, T.ls, 0, 0, 0);
    }
}
__device__ __forceinline__ void at_stage_o(const ATile& T, float scale, LAS unsigned char* vt, int lane) {
    const int qi = lane & 31, hi = lane >> 5;
#pragma unroll
    for (int dt = 0; dt < 2; ++dt)
#pragma unroll
        for (int g4 = 0; g4 < 4; ++g4) {
            const f32x16& o = dt == 0 ? T.o0 : T.o1;
            v2u w; w.x = cvt_pk_bf16(o[4 * g4 + 0] * scale, o[4 * g4 + 1] * scale); w.y = cvt_pk_bf16(o[4 * g4 + 2] * scale, o[4 * g4 + 3] * scale);
            *(LAS v2u*)(vt + qi * VSTR + (32 * dt + 8 * g4 + 4 * hi) * 2) = w;
        }
    asm volatile("" ::: "memory");
}
__device__ __forceinline__ v4u mul_bf16x8(v4u a, v4u g) {
    v4u w;
    w.x = cvt_pk_bf16(bf_lo(a.x) * bf_lo(g.x), bf_hi(a.x) * bf_hi(g.x)); w.y = cvt_pk_bf16(bf_lo(a.y) * bf_lo(g.y), bf_hi(a.y) * bf_hi(g.y));
    w.z = cvt_pk_bf16(bf_lo(a.z) * bf_lo(g.z), bf_hi(a.z) * bf_hi(g.z)); w.w = cvt_pk_bf16(bf_lo(a.w) * bf_lo(g.w), bf_hi(a.w) * bf_hi(g.w));
    return w;
}
__device__ __forceinline__ void at_store_gated(const ATile& T, float scale, const bf16* gate0, bf16* out0, LAS unsigned char* vt, int lane) {
    at_stage_o(T, scale, vt, lane);
#pragma unroll
    for (int i = 0; i < 4; ++i) {
        const int r = 8 * i + (lane >> 3), ch = lane & 7;
        const v4u o = *(const LAS v4u*)(vt + r * VSTR + ch * 16);
        const v4u g = *(const v4u*)(gate0 + (size_t)r * HD + ch * 8);
        *(v4u*)(out0 + (size_t)r * BRP + ch * 8) = mul_bf16x8(o, g);
    }
    asm volatile("" ::: "memory");
}

constexpr int TABN = 2128;
template <int MODE> __device__ __forceinline__ void moba_unit(Frame& F, int b, int h, int qb) {
    LAS float* tab4 = (LAS float*)(F.lds + AT_TAB);
    LAS float* kml = (LAS float*)(F.lds + AT_KM2);
    LAS unsigned char* kring = F.lds + AT_RING2;
    const int lane = F.lane, qi = lane & 31, hi = lane >> 5, tid = F.tid;
    __syncthreads();
    for (int y = tid; y < TABN + 3; y += NWAVES * 64) {
        const int dlt = 2047 - y; const float v = dlt >= 0 ? F_BIAS[(OFF_A + h) * SEQ + dlt] : -INFINITY;
#pragma unroll
        for (int k = 0; k < 4; ++k) { const int i = y - k; if (i >= 0 && i < TABN) tab4[k * TABN + i] = v; }
    }
    for (int i = tid; i < qb * 64; i += NWAVES * 64) { const int kb = i >> 6, d = i & 63, pm = b * 8 + kb;
        kml[i] = F_KM[((size_t)(0 * 64 + pm) * 8 + h) * 64 + d] + F_KM[((size_t)(1 * 64 + pm) * 8 + h) * 64 + d]; }
    const size_t rowb = (size_t)b * SEQ;
    const bf16* Kg = PHEAD(8 + h) + rowb * HD; const bf16* Vg = PHEAD(16 + h) + rowb * HD;
    const int ntile = 4 * (qb + 1);
    v4u rk = *(const v4u*)(Kg + tid * 8), rv = *(const v4u*)(Vg + tid * 8);
    const int soff = (tid >> 3) * VSTR + (tid & 7) * 16;
    __syncthreads();
    const int tq0 = qb * 256 + 32 * F.wave;
    const size_t qrow = rowb + tq0 + qi;
    bf16x8 qf[4];
#pragma unroll
    for (int ks = 0; ks < 4; ++ks) qf[ks] = *(const bf16x8*)(PHEAD(0 + h) + qrow * HD + 16 * ks + 8 * hi);
    unsigned selmask = (1u << qb) - 1u;
    if (qb > 3) {
        float gt[7];
#pragma unroll
        for (int kb = 0; kb < 7; ++kb) {
            float a = 0.f;
            if (kb < qb) {
#pragma unroll
                for (int ks = 0; ks < 4; ++ks)
#pragma unroll
                    for (int j = 0; j < 8; ++j) a += __builtin_bit_cast(float, ((unsigned)(unsigned short)qf[ks][j]) << 16) * kml[kb * 64 + 16 * ks + 8 * hi + j];
                a += __shfl_xor(a, 32);
            }
            gt[kb] = a;
        }
        selmask = 0u;
#pragma unroll
        for (int pick = 0; pick < 3; ++pick) {
            float best = -INFINITY; int bi = 0;
#pragma unroll
            for (int kb = 0; kb < 7; ++kb) { const bool ok = (kb < qb) && !((selmask >> kb) & 1u) && (gt[kb] > best); best = ok ? gt[kb] : best; bi = ok ? kb : bi; }
            selmask |= 1u << bi;
        }
    }
    *(LAS v4u*)(kring + soff) = rk; *(LAS v4u*)(kring + 64 * VSTR + soff) = rv;
    __syncthreads();
    const int kcopy = (3 - qi) & 3;
    const LAS float* tabk = tab4 + kcopy * TABN;
    const int ybase = 2047 - (tq0 + qi) + 4 * hi - kcopy;
    ATile T; T.init();
    for (int t = 0; t < ntile; ++t) {
        LAS unsigned char* slot = kring + (t & 1) * (128 * VSTR);
        if (MODE != 3 && t + 1 < ntile) { rk = *(const v4u*)(Kg + (size_t)(t + 1) * 4096 + tid * 8); rv = *(const v4u*)(Vg + (size_t)(t + 1) * 4096 + tid * 8); }
        const int kb = t >> 2, j = t & 3;
        const bool own = (kb == qb);
        const bool sel = own || ((selmask >> kb) & 1u);
        const bool need = own ? (2 * j <= F.wave) : (__any(sel) != 0);
        if (need && MODE != 2) {
            const int tk0 = kb * 256 + 64 * j;
            f32x16 s[2];
            bf16x8 k0[4], k1[4];
            { const LAS unsigned char* kp = slot + qi * VSTR + 16 * hi;
#pragma unroll
              for (int ks = 0; ks < 4; ++ks) { k0[ks] = *(const LAS bf16x8*)(kp + 32 * ks); k1[ks] = *(const LAS bf16x8*)(kp + 32 * VSTR + 32 * ks); }
              const LAS float* tp = tabk + (sel ? ybase + tk0 : 2048);
              s[0] = at_bias(tp); s[1] = at_bias(tp + 32); }
            __builtin_amdgcn_sched_barrier(0);
#pragma unroll
            for (int ks = 0; ks < 4; ++ks) {
                s[0] = __builtin_amdgcn_mfma_f32_32x32x16_bf16(k0[ks], qf[ks], s[0], 0, 0, 0);
                s[1] = __builtin_amdgcn_mfma_f32_32x32x16_bf16(k1[ks], qf[ks], s[1], 0, 0, 0);
            }
            __builtin_amdgcn_sched_barrier(0);
            at_step<2>(T, s, slot + 64 * VSTR, lane);
        }
        if (t + 1 < ntile) { LAS unsigned char* nslot = kring + ((t + 1) & 1) * (128 * VSTR); *(LAS v4u*)(nslot + soff) = rk; *(LAS v4u*)(nslot + 64 * VSTR + soff) = rv; }
        __syncthreads();
    }
    const float ltot = T.ls[0];
    if (MODE != 0) { asm volatile("" :: "v"(T.o0), "v"(T.o1), "v"(ltot)); return; }
    { const size_t q0 = rowb + tq0; at_store_gated(T, 1.0f / ltot, PHEAD(24 + h) + q0 * HD, F_BR + q0 * BRP + 0 * WBR + h * 64, F.lds + AT_VT + F.wave * AT_VT_WAVE, lane); }
}

constexpr int TABS = 208;
__device__ __forceinline__ void swa_unit(Frame& F, int b, int spn, int hq, const float* sinks_l) {
    LAS float* tab4 = (LAS float*)(F.lds + AT_TAB);
    LAS unsigned char* vt = F.lds + AT_VT + F.wave * AT_VT_WAVE;
    const int lane = F.lane, qi = lane & 31, hi = lane >> 5;
    __syncthreads();
    for (int i = F.tid; i < 4 * TABS; i += NWAVES * 64) { const int k = i / TABS, y = i % TABS + k, dlt = 160 - y; tab4[i] = (dlt >= 0 && dlt < 128) ? F_BIAS[(OFF_C + hq) * SEQ + dlt] : -INFINITY; }
    __syncthreads();
    const int tq0 = spn * 256 + 32 * F.wave, kvh = hq >> 2;
    const size_t rowb = (size_t)b * SEQ, qrow = rowb + tq0 + qi;
    bf16x8 qf[4];
#pragma unroll
    for (int ks = 0; ks < 4; ++ks) qf[ks] = *(const bf16x8*)(PHEAD(112 + hq) + qrow * HD + 16 * ks + 8 * hi);
    const bf16* Kg = PHEAD(120 + kvh) + rowb * HD; const bf16* Vg = PHEAD(122 + kvh) + rowb * HD;
    int kt0 = 4 - (tq0 >> 5); kt0 = kt0 < 0 ? 0 : kt0;
    const int kcopy = (0 - qi) & 3;
    const LAS float* tabk = tab4 + kcopy * TABS + (32 - qi + 4 * hi - kcopy);
    ATile T; T.init();
    KVregs A; { const int tk0 = tq0 - 128 + 32 * kt0; at_load_kv(A, Kg + (size_t)tk0 * HD, Vg + (size_t)tk0 * HD, lane); }
    for (int kt = kt0; kt < 5; ++kt) {
        KVregs Bn; { const int ktn = kt + 1 < 5 ? kt + 1 : 4; const int tkn = tq0 - 128 + 32 * ktn; at_load_kv(Bn, Kg + (size_t)tkn * HD, Vg + (size_t)tkn * HD, lane); }
        at_stage_v(A.vr, vt, lane);
        f32x16 s[1]; s[0] = at_bias(tabk + 32 * kt);
        __builtin_amdgcn_sched_barrier(0);
#pragma unroll
        for (int ks = 0; ks < 4; ++ks) s[0] = __builtin_amdgcn_mfma_f32_32x32x16_bf16(A.kf[ks], qf[ks], s[0], 0, 0, 0);
        at_step<1>(T, s, vt, lane);
        A = Bn;
    }
    const float sk = sinks_l[hq] * LOG2E;
    const float ltot = T.ls[0] + __builtin_amdgcn_exp2f(sk);
    { const size_t q0 = rowb + tq0; at_store_gated(T, 1.0f / ltot, PHEAD(124 + hq) + q0 * HD, F_BR + q0 * BRP + 2 * WBR + hq * 64, vt, lane); }
}

constexpr int B_TAB = 36864, B_L = B_TAB + 3 * 4 * 208 * 4, B_O = 49152, B_OSTR = 144;
static_assert(B_L + 512 * 4 <= B_O && B_O + 512 * B_OSTR <= RING_BYTES, "dilated LDS map");
template <int MODE> __device__ __forceinline__ void dil_unit(Frame& F, int b, int h, int sp) {
    LAS float* tab4 = (LAS float*)(F.lds + B_TAB);
    LAS float* lacc = (LAS float*)(F.lds + B_L);
    LAS unsigned char* oacc = F.lds + B_O;
    LAS unsigned char* vt = F.lds + AT_VT + F.wave * AT_VT_WAVE;
    const int lane = F.lane, qi = lane & 31, hi = lane >> 5;
    const size_t rowb = (size_t)b * SEQ;
    __syncthreads();
    for (int i = F.tid; i < 3 * 4 * TABS; i += NWAVES * 64) { const int g = i / (4 * TABS), k = (i / TABS) & 3, y = i % TABS + k, dlt = 160 - y, dil = 1 << (2 * g);
        tab4[i] = (dlt >= 0 && dlt <= 128) ? F_BIAS[(OFF_B + g * 8 + h) * SEQ + (dil * dlt > 2047 ? 2047 : dil * dlt)] : -INFINITY; }
    __syncthreads();
    const int kcopy = (0 - qi) & 3;
    for (int g = 0; g < 3; ++g) {
        const int dsh = 2 * g, dil = 1 << dsh;
        for (int t2 = 0; t2 < 2; ++t2) {
            const int tt = 2 * F.wave + t2;
            int res, pq0, nkt, pkb;
            if (g == 0)      { res = 0;       pq0 = 512 * sp + 32 * tt;       nkt = 5;      pkb = pq0 - 128; }
            else if (g == 1) { res = tt >> 2; pq0 = 128 * sp + 32 * (tt & 3); nkt = 5;      pkb = pq0 - 128; }
            else             { res = tt;      pq0 = 32 * sp;                  nkt = sp + 1; pkb = 0; }
            int kt0 = (pkb < 0) ? ((-pkb) >> 5) : 0;
            const int pq = pq0 + qi;
            const size_t rbase = rowb + (size_t)res * (SEQ >> dsh);
            bf16x8 qf[4];
#pragma unroll
            for (int ks = 0; ks < 4; ++ks) qf[ks] = *(const bf16x8*)(PHEAD(32 + g * 8 + h) + (rbase + pq) * HD + 16 * ks + 8 * hi);
            const bf16* Kg = PHEAD(56 + g * 8 + h) + rbase * HD; const bf16* Vg = PHEAD(80 + g * 8 + h) + rbase * HD;
            const LAS float* tabk = tab4 + (g * 4 + kcopy) * TABS + (160 - (pq0 - pkb) - qi + 4 * hi - kcopy);
            ATile T; T.init();
            KVregs A, B1;
            { const int pk0 = pkb + 32 * kt0; at_load_kv(A, Kg + (size_t)pk0 * HD, Vg + (size_t)pk0 * HD, lane);
              const int kt1 = kt0 + 1 < nkt ? kt0 + 1 : nkt - 1; const int pk1 = pkb + 32 * kt1; at_load_kv(B1, Kg + (size_t)pk1 * HD, Vg + (size_t)pk1 * HD, lane); }
            for (int kt = kt0; kt < nkt; ++kt) {
                KVregs C2; if (MODE != 3) { const int ktn = kt + 2 < nkt ? kt + 2 : nkt - 1; const int pkn = pkb + 32 * ktn; at_load_kv(C2, Kg + (size_t)pkn * HD, Vg + (size_t)pkn * HD, lane); } else C2 = A;
                if (MODE == 2) { asm volatile("" :: "v"(A.kf[0]), "v"(A.kf[1]), "v"(A.kf[2]), "v"(A.kf[3]), "v"(A.vr[0]), "v"(A.vr[1]), "v"(A.vr[2]), "v"(A.vr[3])); A = B1; B1 = C2; continue; }
                at_stage_v(A.vr, vt, lane);
                f32x16 s[1]; s[0] = at_bias(tabk + 32 * kt);
                __builtin_amdgcn_sched_barrier(0);
#pragma unroll
                for (int ks = 0; ks < 4; ++ks) s[0] = __builtin_amdgcn_mfma_f32_32x32x16_bf16(A.kf[ks], qf[ks], s[0], 0, 0, 0);
                at_step<1>(T, s, vt, lane);
                A = B1; B1 = C2;
            }
            const float ltile = T.ls[0];
            if (MODE != 0) { asm volatile("" :: "v"(T.o0), "v"(T.o1), "v"(ltile)); continue; }
            const int trow = dil * pq + res - 512 * sp;
            LAS unsigned char* orow = oacc + trow * B_OSTR + 8 * hi;
            float lsum = ltile, inv = 1.f;
            if (g > 0) lsum += lacc[trow];
            if (g == 2) inv = 1.0f / lsum;
#pragma unroll
            for (int dt = 0; dt < 2; ++dt)
#pragma unroll
                for (int g4 = 0; g4 < 4; ++g4) {
                    const f32x16& o = dt == 0 ? T.o0 : T.o1;
                    float v0 = o[4 * g4 + 0], v1 = o[4 * g4 + 1], v2 = o[4 * g4 + 2], v3 = o[4 * g4 + 3];
                    LAS v2u* p = (LAS v2u*)(orow + 64 * dt + 16 * g4);
                    if (g > 0) { const v2u a = *p; v0 += bf_lo(a.x); v1 += bf_hi(a.x); v2 += bf_lo(a.y); v3 += bf_hi(a.y); }
                    v2u w; w.x = cvt_pk_bf16(v0 * inv, v1 * inv); w.y = cvt_pk_bf16(v2 * inv, v3 * inv);
                    *p = w;
                }
            if (g < 2 && hi == 0) lacc[trow] = lsum;
        }
        __syncthreads();
    }
    if (MODE == 0) {
        const int ch = F.tid & 7;
#pragma unroll 4
        for (int i = 0; i < 8; ++i) {
            const int tl = 64 * i + (F.tid >> 3);
            const size_t row = rowb + 512 * sp + tl;
            const v4u o = *(const LAS v4u*)(oacc + tl * B_OSTR + ch * 16);
            const v4u gg = *(const v4u*)(PHEAD(104 + h) + row * HD + ch * 8);
            *(v4u*)(F_BR + row * BRP + 1 * WBR + h * 64 + ch * 8) = mul_bf16x8(o, gg);
        }
    }
}

__device__ __forceinline__ void attn_phase(Frame& F0, int layer) {
    Frame F = F0; asm volatile("" : "+v"(F.tid), "+v"(F.lane));
    if (DBG_TWICE & 4) for (int u = F.vcu; u < 256; u += F.G) { const int bh = u >> 2, pr = u & 3; moba_unit<DBG_MODE>(F, bh >> 3, bh & 7, pr); moba_unit<DBG_MODE>(F, bh >> 3, bh & 7, 7 - pr); }
    for (int u = F.vcu; u < 256; u += F.G) { const int bh = u >> 2, pr = u & 3; moba_unit<0>(F, bh >> 3, bh & 7, pr); moba_unit<0>(F, bh >> 3, bh & 7, 7 - pr); }
    if (DBG_TWICE & 8) for (int u = F.vcu; u < 256; u += F.G) { const int bh = u >> 2, sp = u & 3; dil_unit<DBG_MODE>(F, bh >> 3, bh & 7, sp); }
    for (int u = F.vcu; u < 256; u += F.G) { const int bh = u >> 2, sp = u & 3; dil_unit<0>(F, bh >> 3, bh & 7, sp); }
    for (int rep = 0; rep < ((DBG_TWICE & 16) ? 2 : 1); ++rep)
    for (int u = F.vcu; u < 512; u += F.G) { const int hq = u & 7, spn = (u >> 3) & 7, b = u >> 6; swa_unit(F, b, spn, hq, F_SINK + layer * 8); }
    __syncthreads();
}

struct Args { const float* in[8]; float* out; unsigned char* ws; int ph_lo, ph_hi; };
__global__ void __launch_bounds__(NWAVES * 64, 2) trunk_fwd(Args args) {
    extern __shared__ __attribute__((aligned(16))) unsigned char lds[];
    Frame F;
    F.lds = (LAS unsigned char*)lds;
    F.tid = threadIdx.x; F.lane = F.tid & 63; F.wave = __builtin_amdgcn_readfirstlane(F.tid >> 6);
    F.G = gridDim.x; { const int bx = blockIdx.x; F.vcu = (F.G % 8 == 0) ? (bx % 8) * (F.G / 8) + bx / 8 : bx; }
    unsigned char* ws = args.ws;
    F.x = args.in[0]; F.ws = ws;
    F.out = args.out;
    for (int u = F.tid; u < (LDS_BYTES - LDSCTL_OFF) / 4; u += NWAVES * 64) ((LAS unsigned*)(F.lds + LDSCTL_OFF))[u] = 0u;
    __syncthreads();
    XcdBarrier bar; bar.bar = (unsigned*)(ws + WS_CTL) + CW_BAR; bar.x = 0; bar.st = nullptr;
    if (!MK_PER_PHASE) bar = xcd_barrier_post((unsigned*)(ws + WS_CTL) + CW_BAR, (volatile LAS unsigned*)(F.lds + MISC_OFF) + 8);
    const int lo = args.ph_lo, hi = args.ph_hi;
#define IN(k) (lo <= (k) && (k) < hi)
#define SEAM(k) do { if (IN(k) && IN((k) + 1)) xcd_barrier(bar); } while (0)
    if (IN(0) && (DBG_PH & 1)) { for (int rep = 0; rep < ((DBG_TWICE & 1) ? 2 : 1); ++rep) p0_prologue(F, args.in[1], args.in[2], args.in[3], args.in[4], args.in[5], args.in[6], args.in[7]); SEAM(0); }
    for (int l = 0; l < DEPTH; ++l) {
        const int p1 = 1 + 4 * l;
        if (IN(p1) && (DBG_PH & 2)) {
            pg8::Gemm g{F_XB, F_WINT + (size_t)l * CIN * DM, M, CIN, DM}; pg8::StaticOrder S; S.init(M, CIN, F.G, (int)blockIdx.x);
            pg8::EpiProj E{F_P, F_SSQ, F_QKG + l * 6 * HD, F_KM};
            if (G1_STAGGER_TICKS > 0) {
                if (F.tid == 0) { const unsigned long long t0 = __builtin_amdgcn_s_memrealtime(), dt = (unsigned long long)(((unsigned)blockIdx.x >> 3) & 3u) * G1_STAGGER_TICKS;
                    while (__builtin_amdgcn_s_memrealtime() - t0 < dt) __builtin_amdgcn_s_sleep(8); }
                __syncthreads();
            }
            if (DBG_TWICE & 128) { pg8::EpiProjT<false> EN{F_P, F_SSQ, F_QKG + l * 6 * HD, F_KM}; pg8::gemm_phase<pg8::EpiProjT<false>, pg8::StaticOrder, true, true>(F.lds + RING_OFF, g, S, EN); }
            if (DBG_TWICE & 64) { pg8::EpiNull EN; pg8::gemm_phase<pg8::EpiNull, pg8::StaticOrder, true, true>(F.lds + RING_OFF, g, S, EN); }
            for (int rep = 0; rep < ((DBG_TWICE & 2) ? 2 : 1); ++rep) pg8::gemm_phase<pg8::EpiProj, pg8::StaticOrder, true, true>(F.lds + RING_OFF, g, S, E);
            if (l + 1 < DEPTH) {
                const int nwg = (M / 256) * (CIN / 256), G = F.G, rounds = (nwg + G - 1) / G, nbusy = nwg - (rounds - 1) * G;
                const int c = (int)blockIdx.x;
                if (nbusy == G || c >= nbusy) {
                    Frame F2 = F; asm volatile("" : "+v"(F2.tid), "+v"(F2.lane));
                    const float* const* pp = (const float* const*)(F.ws + WS_PTRS);
                    __syncthreads();
                    convert_layer(F2, l + 1, nbusy == G ? c : c - nbusy, nbusy == G ? G : G - nbusy, pp[0], pp[1], pp[2], pp[3]);
                }
            }
            SEAM(p1);
        }
        if (IN(p1 + 1) && (DBG_PH & 4)) { attn_phase(F, l); SEAM(p1 + 1); }
        if (IN(p1 + 2) && (DBG_PH & 8)) {
            pg8::Gemm g{F_BR, F_WBRT + (size_t)l * DM * BRP, M, DM, BRP}; pg8::StaticOrder S; S.init(M, DM, F.G, (int)blockIdx.x);
            pg8::EpiMerge E{F_P, F_MG};
            if (DBG_TWICE & 256) { pg8::EpiNull EN; pg8::gemm_phase<pg8::EpiNull, pg8::StaticOrder, true, true>(F.lds + RING_OFF, g, S, EN); }
            for (int rep = 0; rep < ((DBG_TWICE & 32) ? 2 : 1); ++rep) pg8::gemm_phase<pg8::EpiMerge, pg8::StaticOrder, true, true>(F.lds + RING_OFF, g, S, E);
            SEAM(p1 + 2);
        }
        if (IN(p1 + 3) && (DBG_PH & 16)) {
            pg8::Gemm g{F_MG, F_WOUTT + (size_t)l * DM * DM, M, DM, DM}; pg8::StaticOrder S; S.init(M, DM, F.G, (int)blockIdx.x);
            pg8::EpiRes E{l == 0 ? F.x : F.out, F.out, F_XB, F_SSQ};
            pg8::gemm_phase<pg8::EpiRes, pg8::StaticOrder, false, true>(F.lds + RING_OFF, g, S, E);
            if (l + 1 < DEPTH) SEAM(p1 + 3);
        }
    }
#undef IN
#undef SEAM
}

extern "C" void kernel_launch(void* const* d_in, const int* in_sizes, int n_in, void* d_out, int out_size, void* d_ws, size_t ws_size, hipStream_t stream) {
    static int grid = 0;
    if (grid == 0) {
        if (n_in != 8 || in_sizes[0] != M * DM || out_size != M * DM || ws_size < WS_END) { fprintf(stderr, "kernel_launch: unexpected shapes (n_in %d, in0 %d, out %d, ws %zu need %zu); nothing launched\n", n_in, n_in > 0 ? in_sizes[0] : -1, out_size, ws_size, (size_t)WS_END); grid = -1; return; }
        int dev = 0, cus = 0, per_cu = 0;
        if (hipGetDevice(&dev) != hipSuccess || hipDeviceGetAttribute(&cus, hipDeviceAttributeMultiprocessorCount, dev) != hipSuccess) { fprintf(stderr, "kernel_launch: device query failed\n"); grid = -1; return; }
        if (hipFuncSetAttribute((const void*)trunk_fwd, hipFuncAttributeMaxDynamicSharedMemorySize, LDS_BYTES) != hipSuccess) { fprintf(stderr, "kernel_launch: hipFuncSetAttribute failed\n"); grid = -1; return; }
        if (hipOccupancyMaxActiveBlocksPerMultiprocessor(&per_cu, (const void*)trunk_fwd, NWAVES * 64, LDS_BYTES) != hipSuccess || per_cu < 1) fprintf(stderr, "kernel_launch: note: occupancy query reports %d workgroups per CU\n", per_cu);
        (void)hipGetLastError();
        grid = cus;
    }
    if (grid < 0) return;
    if (hipMemsetAsync((char*)d_ws + WS_CTL, 0, CTL_ZERO_BYTES, stream) != hipSuccess) { fprintf(stderr, "kernel_launch: memset failed\n"); return; }
    Args a{};
    for (int i = 0; i < 8; ++i) a.in[i] = (const float*)d_in[i];
    a.out = (float*)d_out; a.ws = (unsigned char*)d_ws;
#if MK_PER_PHASE
    for (int p = 0; p < N_PHASES; ++p) { a.ph_lo = p; a.ph_hi = p + 1; hipLaunchKernelGGL(trunk_fwd, dim3(grid), dim3(NWAVES * 64), LDS_BYTES, stream, a); }
#else
    a.ph_lo = 0; a.ph_hi = N_PHASES;
    hipLaunchKernelGGL(trunk_fwd, dim3(grid), dim3(NWAVES * 64), LDS_BYTES, stream, a);
#endif
    const hipError_t le = hipPeekAtLastError();
    if (le != hipSuccess) fprintf(stderr, "kernel_launch: launch failed: %s\n", hipGetErrorName(le));
}
```
